# Optimizing an MI355X kernel written in HIP

```python
import math
import jax
import jax.numpy as jnp
from jax import lax
import numpy as np

D_MODEL = 1024
BATCH = 2
SEQ = 8192
DEPTH = 1

GRID_W = 64
CTX_LEN = 256
EPS = 1e-6
DA_HEADS = 4
DA_D = 64
DA_DV = 2 * DA_D
ROPE_AXIS_DIM = DA_D // 2
ROPE_THETA = 10000.0
Q_BLOCK = 128
GDN_HEADS = 4
GDN_DK = 128
GDN_DV = 128
CONV_K = 3
CHUNK = 64
N_EXPERTS = 16
EXPERT_FF = 1024
CAP_FACTOR = 2
DA_QK = DA_HEADS * 2 * DA_D
DA_V = DA_HEADS * DA_DV
GDN_QK = GDN_HEADS * GDN_DK
GDN_V = GDN_HEADS * GDN_DV
GDN_QKV = 2 * GDN_QK + GDN_V
GDN_AB = 2 * 2 * GDN_HEADS
D_MIX = DA_V + GDN_V
IN_SPLIT_POINTS = (DA_QK, 2 * DA_QK, 2 * DA_QK + DA_V, 2 * DA_QK + DA_V + GDN_QKV, 2 * DA_QK + DA_V + GDN_QKV + GDN_V)
IN_COLS = 2 * DA_QK + DA_V + GDN_QKV + GDN_V + GDN_AB

kernel_name = 'hybrid_diffattn_gdn_ecmoe_dit_layer'


def rms_norm(x, g):
    xf = x.astype(jnp.float32)
    y = xf * lax.rsqrt(jnp.mean(xf * xf, axis=-1, keepdims=True) + EPS)
    return (y * g.astype(jnp.float32)).astype(x.dtype)


def modulate(x, g, shift, scale):
    return rms_norm(x, g) * (1.0 + scale) + shift


def l2_normalize(t):
    tf = t.astype(jnp.float32)
    return (tf * lax.rsqrt(jnp.sum(tf * tf, axis=-1, keepdims=True) + EPS)).astype(t.dtype)


def rope_axis(x, ang):
    cos = jnp.cos(ang).astype(x.dtype)[:, None, None, :]
    sin = jnp.sin(ang).astype(x.dtype)[:, None, None, :]
    x1, x2 = jnp.split(x, 2, axis=-1)
    return jnp.concatenate([x1 * cos - x2 * sin, x2 * cos + x1 * sin], axis=-1)


def rope_2d(x, ang_row, ang_col):
    xr, xc = jnp.split(x, 2, axis=-1)
    return jnp.concatenate([rope_axis(xr, ang_row), rope_axis(xc, ang_col)], axis=-1)


def diff_attn(q, k, v, lam):
    B, L = q.shape[:2]
    nblk = L // Q_BLOCK
    qb = jnp.moveaxis((q * DA_D ** -0.5).reshape(B, nblk, Q_BLOCK, DA_HEADS, 2, DA_D), 1, 0)

    def block(qi):
        s = jnp.einsum('bqhid,bkhid->bhiqk', qi, k).astype(jnp.float32)
        p = jax.nn.softmax(s, axis=-1)
        a = (p[:, :, 0] - lam * p[:, :, 1]).astype(v.dtype)
        return jnp.einsum('bhqk,bkhe->bqhe', a, v)

    o = lax.map(block, qb)
    return jnp.moveaxis(o, 0, 1).reshape(B, L, DA_HEADS, DA_DV)


def short_conv(x, w):
    L = x.shape[1]
    p = CONV_K // 2
    xp = jnp.pad(x, ((0, 0), (p, p), (0, 0)))
    return jax.nn.silu(sum(xp[:, i:i + L] * w[i] for i in range(CONV_K)))


def gdn_inputs(qkv, ab, conv_w, a_log, dt_bias):
    B, L = qkv.shape[:2]
    q, k, v = jnp.split(short_conv(qkv, conv_w), [GDN_QK, 2 * GDN_QK], axis=-1)
    q = l2_normalize(q.reshape(B, L, GDN_HEADS, GDN_DK)) * GDN_DK ** -0.5
    k = l2_normalize(k.reshape(B, L, GDN_HEADS, GDN_DK))
    v = v.reshape(B, L, GDN_HEADS, GDN_DV)
    ab = ab.reshape(B, L, 2, 2, GDN_HEADS).astype(jnp.float32)
    g = -jnp.exp(a_log.astype(jnp.float32)) * jax.nn.softplus(ab[:, :, 0] + dt_bias.astype(jnp.float32))
    beta = jax.nn.sigmoid(ab[:, :, 1])
    return q, k, v, g, beta


def gdn_chunked(q, k, v, g, beta, s0, need_out):
    B, L, H, dk = k.shape
    dv = v.shape[-1]
    n = L // CHUNK
    f32 = jnp.float32

    def chunks(t):
        t = t.astype(f32).reshape(B, n, CHUNK, *t.shape[2:])
        return jnp.moveaxis(t, (1, 3), (0, 2))

    kc, vc, gc, bc = chunks(k), chunks(v), chunks(g), chunks(beta)
    Gc = jnp.cumsum(gc, axis=-1)
    diff = Gc[..., :, None] - Gc[..., None, :]
    idx = jnp.arange(CHUNK)
    strict = idx[:, None] > idx[None, :]
    dec_strict = jnp.where(strict, jnp.exp(jnp.where(strict, diff, 0.0)), 0.0)
    a_mat = jnp.eye(CHUNK, dtype=f32) + bc[..., None] * jnp.einsum('nbhid,nbhjd->nbhij', kc, kc) * dec_strict
    rhs = jnp.concatenate([(bc * jnp.exp(Gc))[..., None] * kc, bc[..., None] * vc], axis=-1)
    sol = lax.linalg.triangular_solve(a_mat, rhs, left_side=True, lower=True, unit_diagonal=True)
    w, ub = sol[..., :dk], sol[..., dk:]
    kd = kc * jnp.exp(Gc[..., -1:] - Gc)[..., None]
    g_last = jnp.exp(Gc[..., -1])[..., None, None]

    if need_out:
        qc = chunks(q)
        incl = idx[:, None] >= idx[None, :]
        dec_incl = jnp.where(incl, jnp.exp(jnp.where(incl, diff, 0.0)), 0.0)
        qd = qc * jnp.exp(Gc)[..., None]
        aqk = jnp.einsum('nbhid,nbhjd->nbhij', qc, kc) * dec_incl

        def step(s, xs):
            w_n, ub_n, kd_n, gl_n, qd_n, aqk_n = xs
            u = ub_n - jnp.einsum('bhcd,bhde->bhce', w_n, s)
            o = jnp.einsum('bhcd,bhde->bhce', qd_n, s) + jnp.einsum('bhij,bhje->bhie', aqk_n, u)
            return gl_n * s + jnp.einsum('bhcd,bhce->bhde', kd_n, u), o

        s_fin, o = lax.scan(step, s0, (w, ub, kd, g_last, qd, aqk))
        o = jnp.moveaxis(o, (0, 2), (1, 3)).reshape(B, L, H, dv).astype(v.dtype)
        return o, s_fin

    def step_state(s, xs):
        w_n, ub_n, kd_n, gl_n = xs
        u = ub_n - jnp.einsum('bhcd,bhde->bhce', w_n, s)
        return gl_n * s + jnp.einsum('bhcd,bhce->bhde', kd_n, u), None

    s_fin, _ = lax.scan(step_state, s0, (w, ub, kd, g_last))
    return None, s_fin


def bidirectional_gdn(lat, ctx_in, need_ctx_out):
    ql, kl, vl, gl, bl = lat
    qc, kc, vc, gc, bc = ctx_in
    B = ql.shape[0]
    o_lat, o_ctx = None, None
    for d in range(2):
        rev = (lambda t: jnp.flip(t, axis=1)) if d == 1 else (lambda t: t)
        s0 = jnp.zeros((B, GDN_HEADS, GDN_DK, GDN_DV), jnp.float32)
        oc, s_ctx = gdn_chunked(rev(qc), rev(kc), rev(vc), rev(gc[:, :, d]), rev(bc[:, :, d]), s0, need_ctx_out)
        ol, _ = gdn_chunked(rev(ql), rev(kl), rev(vl), rev(gl[:, :, d]), rev(bl[:, :, d]), s_ctx, True)
        o_lat = rev(ol) if o_lat is None else o_lat + rev(ol)
        if need_ctx_out:
            o_ctx = rev(oc) if o_ctx is None else o_ctx + rev(oc)
    return o_lat, o_ctx


def gdn_output(o, gate, gdn_norm_g):
    B, L = o.shape[:2]
    y = rms_norm(o, gdn_norm_g) * jax.nn.silu(gate.reshape(B, L, GDN_HEADS, GDN_DV))
    return y.reshape(B, L, GDN_V)


def expert_choice_ffn(h, w_router, w_gate, w_up, w_down):
    def route_set(t):
        n = t.shape[0]
        cap = CAP_FACTOR * n // N_EXPERTS
        aff = jax.nn.softmax((t @ w_router).astype(jnp.float32), axis=-1)
        gate, idx = lax.top_k(aff.T, cap)
        xe = t[idx]
        hid = jax.nn.silu(jnp.einsum('ecd,edf->ecf', xe, w_gate)) * jnp.einsum('ecd,edf->ecf', xe, w_up)
        ye = jnp.einsum('ecf,efd->ecd', hid, w_down) * gate[..., None].astype(t.dtype)
        return jnp.zeros_like(t).at[idx.reshape(-1)].add(ye.reshape(-1, t.shape[-1]))

    return jax.vmap(route_set)(h)


def hybrid_layer(x, xc, c, c_ctx, ang_row, ang_col, lam_init, last,
                 w_mod, b_mod, norm1_g, w_in, conv_w, a_log, dt_bias, gdn_norm_g,
                 lam_q1, lam_k1, lam_q2, lam_k2, da_subln_g, w_out, norm2_g,
                 w_router, w_gate, w_up, w_down):
    B, L, _ = x.shape
    Lc = xc.shape[1]
    sh1, sc1, gt1, sh2, sc2, gt2 = jnp.split((jax.nn.silu(c) @ w_mod + b_mod)[:, None, :], 6, axis=-1)
    sh1c, sc1c, gt1c, sh2c, sc2c, gt2c = jnp.split(jax.nn.silu(c_ctx) @ w_mod + b_mod, 6, axis=-1)

    p = modulate(x, norm1_g, sh1, sc1) @ w_in
    pc = modulate(xc, norm1_g, sh1c, sc1c) @ w_in
    q, k, v, qkv, gate, ab = jnp.split(p, IN_SPLIT_POINTS, axis=-1)
    qc, kc, vc, qkvc, gatec, abc = jnp.split(pc, IN_SPLIT_POINTS, axis=-1)

    lam = (jnp.exp(jnp.sum(lam_q1 * lam_k1, dtype=jnp.float32))
           - jnp.exp(jnp.sum(lam_q2 * lam_k2, dtype=jnp.float32)) + lam_init)
    k_c = kc.reshape(B, Lc, DA_HEADS, 2, DA_D)
    v_c = vc.reshape(B, Lc, DA_HEADS, DA_DV)
    q_l = rope_2d(q.reshape(B, L, DA_HEADS, 2, DA_D), ang_row, ang_col)
    k_l = rope_2d(k.reshape(B, L, DA_HEADS, 2, DA_D), ang_row, ang_col)
    o_da = diff_attn(q_l, jnp.concatenate([k_c, k_l], axis=1),
                     jnp.concatenate([v_c, v.reshape(B, L, DA_HEADS, DA_DV)], axis=1), lam)
    o_da = (rms_norm(o_da, da_subln_g) * (1.0 - lam_init)).reshape(B, L, DA_V)

    o_gdn_l, o_gdn_c = bidirectional_gdn(gdn_inputs(qkv, ab, conv_w, a_log, dt_bias),
                                         gdn_inputs(qkvc, abc, conv_w, a_log, dt_bias), not last)
    o_gdn = gdn_output(o_gdn_l, gate, gdn_norm_g)

    x_new = x + gt1 * (jnp.concatenate([o_da, o_gdn], axis=-1) @ w_out)
    x_new = x_new + gt2 * expert_choice_ffn(modulate(x_new, norm2_g, sh2, sc2), w_router, w_gate, w_up, w_down)

    if not last:
        o_da_c = diff_attn(qc.reshape(B, Lc, DA_HEADS, 2, DA_D), k_c, v_c, lam)
        o_da_c = (rms_norm(o_da_c, da_subln_g) * (1.0 - lam_init)).reshape(B, Lc, DA_V)
        xc = xc + gt1c * (jnp.concatenate([o_da_c, gdn_output(o_gdn_c, gatec, gdn_norm_g)], axis=-1) @ w_out)
        xc = xc + gt2c * expert_choice_ffn(modulate(xc, norm2_g, sh2c, sc2c), w_router, w_gate, w_up, w_down)
    return x_new, xc


def setup_inputs(seed: int = 0) -> dict:
    key = jax.random.key(seed)
    ks = jax.random.split(key, 24)
    D = D_MODEL
    f32 = jnp.float32

    def nrm(k, shape, s):
        return jax.random.normal(k, shape, f32) * s

    dt = jnp.exp(jax.random.uniform(ks[10], (DEPTH, 2, GDN_HEADS), f32, math.log(1e-3), math.log(1e-1)))
    return {
        'x': nrm(ks[0], (BATCH, SEQ, D), 1.0),
        'c': nrm(ks[1], (BATCH, D), 1.0),
        'ctx': nrm(ks[2], (BATCH, CTX_LEN, D), 1.0),
        'c_ctx': nrm(ks[3], (D,), 1.0),
        'w_mod': nrm(ks[4], (DEPTH, D, 6 * D), 0.5 * D ** -0.5),
        'b_mod': nrm(ks[5], (DEPTH, 6 * D), 0.01),
        'norm1_g': 1.0 + nrm(ks[6], (DEPTH, D), 0.05),
        'w_in': nrm(ks[7], (DEPTH, D, IN_COLS), D ** -0.5),
        'conv_w': nrm(ks[8], (DEPTH, CONV_K, GDN_QKV), CONV_K ** -0.5),
        'a_log': jnp.log(jax.random.uniform(ks[9], (DEPTH, 2, GDN_HEADS), f32, 1.0, 16.0)),
        'dt_bias': dt + jnp.log(-jnp.expm1(-dt)),
        'gdn_norm_g': 1.0 + nrm(ks[11], (DEPTH, GDN_DV), 0.05),
        'lam_q1': nrm(ks[12], (DEPTH, DA_D), 0.1),
        'lam_k1': nrm(ks[13], (DEPTH, DA_D), 0.1),
        'lam_q2': nrm(ks[14], (DEPTH, DA_D), 0.1),
        'lam_k2': nrm(ks[15], (DEPTH, DA_D), 0.1),
        'da_subln_g': 1.0 + nrm(ks[16], (DEPTH, DA_DV), 0.05),
        'w_out': nrm(ks[17], (DEPTH, D_MIX, D), D_MIX ** -0.5),
        'norm2_g': 1.0 + nrm(ks[18], (DEPTH, D), 0.05),
        'w_router': nrm(ks[19], (DEPTH, D, N_EXPERTS), D ** -0.5),
        'w_gate': nrm(ks[20], (DEPTH, N_EXPERTS, D, EXPERT_FF), D ** -0.5),
        'w_up': nrm(ks[21], (DEPTH, N_EXPERTS, D, EXPERT_FF), D ** -0.5),
        'w_down': nrm(ks[22], (DEPTH, N_EXPERTS, EXPERT_FF, D), EXPERT_FF ** -0.5),
        'final_g': 1.0 + nrm(ks[23], (D,), 0.05),
    }


def reference(x, c, ctx, c_ctx, w_mod, b_mod, norm1_g, w_in, conv_w, a_log, dt_bias, gdn_norm_g,
              lam_q1, lam_k1, lam_q2, lam_k2, da_subln_g, w_out, norm2_g,
              w_router, w_gate, w_up, w_down, final_g):
    f32 = jnp.float32
    L = x.shape[1]
    ROWS = L // GRID_W
    rows = jnp.repeat(jnp.arange(ROWS, dtype=f32), GRID_W)
    cols = jnp.tile(jnp.arange(GRID_W, dtype=f32), ROWS)
    inv_freq = jnp.power(ROPE_THETA, -jnp.arange(0, ROPE_AXIS_DIM, 2, dtype=f32) / ROPE_AXIS_DIM)
    ang_row = rows[:, None] * inv_freq[None, :]
    ang_col = cols[:, None] * inv_freq[None, :]

    xc = ctx
    for layer in range(DEPTH):
        lam_init = 0.8 - 0.6 * math.exp(-0.3 * layer)
        x, xc = hybrid_layer(x, xc, c, c_ctx, ang_row, ang_col, lam_init, layer == DEPTH - 1,
                             w_mod[layer], b_mod[layer], norm1_g[layer], w_in[layer], conv_w[layer],
                             a_log[layer], dt_bias[layer], gdn_norm_g[layer],
                             lam_q1[layer], lam_k1[layer], lam_q2[layer], lam_k2[layer], da_subln_g[layer],
                             w_out[layer], norm2_g[layer], w_router[layer], w_gate[layer], w_up[layer], w_down[layer])
    return rms_norm(x, final_g)
```

```cpp
#include <hip/hip_runtime.h>
#include <stdint.h>
#include <stdio.h>

typedef unsigned short bf16_t;
constexpr int D = 1024, NB = 2, L = 8192, LC = 256, LT = L + LC, R = NB * LT, M = NB * L;
constexpr int INC = 3600;
constexpr int NCH = LT / 64;
constexpr int NCI = 2 * NB * 4 * NCH;
constexpr float EPS = 1e-6f;
constexpr size_t MiB = 1u << 20;
constexpr size_t WS_MOD = 4096;
constexpr size_t WS_AFF = 1 * MiB;
constexpr size_t WS_SLOT = 2 * MiB;
constexpr size_t WS_IDXL = 3 * MiB;
constexpr size_t WS_GATEL = 3 * MiB + 256 * 1024;
constexpr size_t WS_G = 4 * MiB;
constexpr size_t WS_BETA = 5 * MiB;
constexpr size_t WS_GCUM = 6 * MiB;
constexpr size_t WS_AB = 7 * MiB;
constexpr size_t WS_H1 = 10 * MiB;
constexpr size_t WS_Q = 43 * MiB;
constexpr size_t WS_K = 59 * MiB;
constexpr size_t WS_V = 76 * MiB;
constexpr size_t WS_GQKV = 93 * MiB;
constexpr size_t WS_GATE = 143 * MiB;
constexpr size_t WS_KQV = 159 * MiB;
constexpr size_t WS_WUB = 209 * MiB;
constexpr size_t WS_AQK = 275 * MiB;
constexpr size_t WS_HID = 43 * MiB;
constexpr size_t WS_YE = 107 * MiB;
constexpr size_t WS_END = 292 * MiB;

__device__ __forceinline__ bf16_t f2bf(float f) { unsigned u = __float_as_uint(f); u += 0x7fffu + ((u >> 16) & 1u); return (bf16_t)(u >> 16); }
__device__ __forceinline__ float bf2f(bf16_t h) { return __uint_as_float(((unsigned)h) << 16); }
__device__ __forceinline__ float siluf(float x) { return x / (1.f + __expf(-x)); }
__device__ __forceinline__ float wave_sum(float v) {
#pragma unroll
    for (int o = 1; o < 64; o <<= 1) v += __shfl_xor(v, o);
    return v;
}

__global__ __launch_bounds__(256) void k_mod(const float* c, const float* c_ctx, const float* w_mod, const float* b_mod,
                                             const float* lq1, const float* lk1, const float* lq2, const float* lk2, float* mod) {
    __shared__ float s[3][1024];
    for (int i = threadIdx.x; i < 1024; i += 256) { s[0][i] = siluf(c[i]); s[1][i] = siluf(c[1024 + i]); s[2][i] = siluf(c_ctx[i]); }
    __syncthreads();
    const int n = blockIdx.x * 256 + threadIdx.x;
    float a0 = b_mod[n], a1 = a0, a2 = a0;
    for (int k = 0; k < 1024; ++k) { const float w = w_mod[(size_t)k * 6144 + n]; a0 += s[0][k] * w; a1 += s[1][k] * w; a2 += s[2][k] * w; }
    mod[n] = a0; mod[6144 + n] = a1; mod[2 * 6144 + n] = a2;
    if (blockIdx.x == 0 && threadIdx.x == 0) {
        float s1 = 0.f, s2 = 0.f;
        for (int i = 0; i < 64; ++i) { s1 += lq1[i] * lk1[i]; s2 += lq2[i] * lk2[i]; }
        mod[3 * 6144] = expf(s1) - expf(s2) + 0.2f;
    }
}

template <int MODE>
__global__ __launch_bounds__(256) void k_norm(const float* x, const float* ctx, const float* g, const float* mod, bf16_t* out,
                                              const float* w_router, float* aff) {
    const int lane = threadIdx.x & 63;
    const int row = blockIdx.x * 4 + (threadIdx.x >> 6);
    const int nrows = MODE == 0 ? R : M;
    if (row >= nrows) return;
    const float* src; int mv;
    if (MODE == 0) { const int b = row / LT, j = row % LT; if (j < LC) { src = ctx + ((size_t)b * LC + j) * D; mv = 2; } else { src = x + ((size_t)b * L + (j - LC)) * D; mv = b; } }
    else { src = x + (size_t)row * D; mv = row / L; }
    const float* sh = mod + mv * 6144 + (MODE == 0 ? 0 : 3072);
    const float* sc = sh + 1024;
    float4 v[4]; float ss = 0.f;
#pragma unroll
    for (int j = 0; j < 4; ++j) { v[j] = *(const float4*)(src + 4 * lane + 256 * j); ss += v[j].x * v[j].x + v[j].y * v[j].y + v[j].z * v[j].z + v[j].w * v[j].w; }
    ss = wave_sum(ss);
    const float rinv = rsqrtf(ss * (1.f / D) + EPS);
    float y[16];
#pragma unroll
    for (int j = 0; j < 4; ++j) {
        const int k0 = 4 * lane + 256 * j;
        const float4 gg = *(const float4*)(g + k0), s1 = *(const float4*)(sc + k0), s0 = *(const float4*)(sh + k0);
        y[4 * j + 0] = v[j].x * rinv * gg.x * (1.f + s1.x) + s0.x;
        y[4 * j + 1] = v[j].y * rinv * gg.y * (1.f + s1.y) + s0.y;
        y[4 * j + 2] = v[j].z * rinv * gg.z * (1.f + s1.z) + s0.z;
        y[4 * j + 3] = v[j].w * rinv * gg.w * (1.f + s1.w) + s0.w;
        ushort4 o; o.x = f2bf(y[4 * j + 0]); o.y = f2bf(y[4 * j + 1]); o.z = f2bf(y[4 * j + 2]); o.w = f2bf(y[4 * j + 3]);
        *(ushort4*)(out + (size_t)row * D + k0) = o;
    }
    if (MODE == 1) {
        float lg[16];
#pragma unroll
        for (int e = 0; e < 16; ++e) lg[e] = 0.f;
#pragma unroll
        for (int j = 0; j < 4; ++j)
#pragma unroll
            for (int i = 0; i < 4; ++i) {
                const int k = 4 * lane + 256 * j + i;
                const float4* wr = (const float4*)(w_router + (size_t)k * 16);
                const float4 w0 = wr[0], w1 = wr[1], w2 = wr[2], w3 = wr[3];
                const float yy = y[4 * j + i];
                lg[0] += yy * w0.x; lg[1] += yy * w0.y; lg[2] += yy * w0.z; lg[3] += yy * w0.w;
                lg[4] += yy * w1.x; lg[5] += yy * w1.y; lg[6] += yy * w1.z; lg[7] += yy * w1.w;
                lg[8] += yy * w2.x; lg[9] += yy * w2.y; lg[10] += yy * w2.z; lg[11] += yy * w2.w;
                lg[12] += yy * w3.x; lg[13] += yy * w3.y; lg[14] += yy * w3.z; lg[15] += yy * w3.w;
            }
        float mx = -1e30f;
#pragma unroll
        for (int e = 0; e < 16; ++e) { lg[e] = wave_sum(lg[e]); mx = fmaxf(mx, lg[e]); }
        float sum = 0.f;
#pragma unroll
        for (int e = 0; e < 16; ++e) { lg[e] = expf(lg[e] - mx); sum += lg[e]; }
        const float inv = 1.f / sum;
        if (lane == 0) {
#pragma unroll
            for (int e = 0; e < 16; ++e) aff[(size_t)row * 16 + e] = lg[e] * inv;
        }
    }
}

struct EpiIn {
    bf16_t *Q, *Kb, *Vb, *GQKV, *GATE; float* AB;
    __device__ __forceinline__ void operator()(int grp, int r, int n, float v, float) const {
        const int b = r / LT, j = r % LT; const bool lat = j >= LC; const size_t m = (size_t)b * L + (j - LC);
        if (n < 512) { if (lat) Q[m * 512 + n] = f2bf(v); }
        else if (n < 1024) Kb[(size_t)r * 512 + (n - 512)] = f2bf(v);
        else if (n < 1536) Vb[(size_t)r * 512 + (n - 1024)] = f2bf(v);
        else if (n < 3072) GQKV[(size_t)r * 1536 + (n - 1536)] = f2bf(v);
        else if (n < 3584) { if (lat) GATE[m * 512 + (n - 3072)] = f2bf(v); }
        else AB[(size_t)r * 16 + (n - 3584)] = v;
    }
};
struct EpiOut {
    const float* x; const float* mod; float* xn;
    __device__ __forceinline__ void operator()(int grp, int m, int n, float v, float) const {
        const int b = m / L; xn[(size_t)m * D + n] = x[(size_t)m * D + n] + mod[b * 6144 + 2048 + n] * v;
    }
};
struct EpiUp {
    bf16_t* hid;
    __device__ __forceinline__ void operator()(int grp, int m, int n, float g, float u) const { hid[((size_t)grp * 1024 + m) * 1024 + n] = f2bf(siluf(g) * u); }
};
struct EpiDown {
    bf16_t* ye; const float* gatel;
    __device__ __forceinline__ void operator()(int grp, int m, int n, float v, float) const { ye[((size_t)grp * 1024 + m) * 1024 + n] = f2bf(v * gatel[grp * 1024 + m]); }
};
template <int GATHER, bool DUAL, class Epi>
__global__ __launch_bounds__(256) void k_gemm(const bf16_t* A, const int* idx, const float* B1, const float* B2, size_t bstride  ,
                                              int Mg, int N, int K, Epi epi) {
    __shared__ float As[16][68];
    __shared__ float Bs[16][68];
    __shared__ float Bs2[DUAL ? 16 : 1][68];
    const int grp = blockIdx.z, m0 = blockIdx.y * 64, n0 = blockIdx.x * 64;
    const int t = threadIdx.x, tx = t & 15, ty = t >> 4;
    const float* Bg1 = B1 + (size_t)(grp & 15) * bstride;
    const float* Bg2 = DUAL ? B2 + (size_t)(grp & 15) * bstride : nullptr;
    const int ar = t >> 2, ak = (t & 3) * 4;
    const bf16_t* arow;
    { const int m = m0 + ar;
      if (GATHER == 0) arow = A + ((size_t)grp * Mg + m) * K;
      else { const int b = grp >> 4; arow = A + ((size_t)b * L + idx[grp * 1024 + m]) * K; } }
    const int bk = t >> 4, bn = (t & 15) * 4;
    float acc[4][4], acc2[4][4];
#pragma unroll
    for (int i = 0; i < 4; ++i)
#pragma unroll
        for (int j = 0; j < 4; ++j) { acc[i][j] = 0.f; acc2[i][j] = 0.f; }
    for (int k0 = 0; k0 < K; k0 += 16) {
        const ushort4 av = *(const ushort4*)(arow + k0 + ak);
        As[ak + 0][ar] = bf2f(av.x); As[ak + 1][ar] = bf2f(av.y); As[ak + 2][ar] = bf2f(av.z); As[ak + 3][ar] = bf2f(av.w);
        {
            float4 bv = make_float4(0.f, 0.f, 0.f, 0.f);
            if (n0 + bn < N) bv = *(const float4*)(Bg1 + (size_t)(k0 + bk) * N + n0 + bn);
            *(float4*)&Bs[bk][bn] = bv;
            if (DUAL) { float4 bv2 = *(const float4*)(Bg2 + (size_t)(k0 + bk) * N + n0 + bn); *(float4*)&Bs2[bk][bn] = bv2; }
        }
        __syncthreads();
#pragma unroll
        for (int k = 0; k < 16; ++k) {
            const float4 a = *(const float4*)&As[k][ty * 4];
            const float4 b = *(const float4*)&Bs[k][tx * 4];
            const float aa[4] = {a.x, a.y, a.z, a.w}; const float bb[4] = {b.x, b.y, b.z, b.w};
#pragma unroll
            for (int i = 0; i < 4; ++i)
#pragma unroll
                for (int j = 0; j < 4; ++j) acc[i][j] += aa[i] * bb[j];
            if (DUAL) {
                const float4 b2 = *(const float4*)&Bs2[k][tx * 4]; const float bb2[4] = {b2.x, b2.y, b2.z, b2.w};
#pragma unroll
                for (int i = 0; i < 4; ++i)
#pragma unroll
                    for (int j = 0; j < 4; ++j) acc2[i][j] += aa[i] * bb2[j];
            }
        }
        __syncthreads();
    }
#pragma unroll
    for (int i = 0; i < 4; ++i)
#pragma unroll
        for (int j = 0; j < 4; ++j) { const int m = m0 + ty * 4 + i, n = n0 + tx * 4 + j; if (n < N) epi(grp, m, n, acc[i][j], acc2[i][j]); }
}

__global__ __launch_bounds__(256) void k_rope(bf16_t* Q, bf16_t* Kb) {
    const size_t gid = (size_t)blockIdx.x * 256 + threadIdx.x;
    const int m = (int)(gid >> 9); const int rem = (int)(gid & 511);
    if (m >= M) return;
    const int which = rem >> 8, hm = (rem >> 5) & 7, axis = (rem >> 4) & 1, j = rem & 15;
    const int b = m / L, tt = m % L;
    const float pos = axis == 0 ? (float)(tt / 64) : (float)(tt % 64);
    const float inv_freq = powf(10000.f, -(float)(2 * j) / 32.f);
    const float ang = pos * inv_freq;
    const float cs = cosf(ang), sn = sinf(ang);
    bf16_t* base = which == 0 ? Q + (size_t)m * 512 : Kb + ((size_t)b * LT + LC + tt) * 512;
    bf16_t* p = base + hm * 64 + axis * 32 + j;
    const float x1 = bf2f(p[0]), x2 = bf2f(p[16]);
    const float sc = which == 0 ? 0.125f : 1.f;
    p[0] = f2bf((x1 * cs - x2 * sn) * sc); p[16] = f2bf((x2 * cs + x1 * sn) * sc);
}

__global__ __launch_bounds__(128) void k_attn(const bf16_t* Q, const bf16_t* Kb, const bf16_t* Vb, const float* mod, const float* subg, bf16_t* CAT) {
    __shared__ float sm[64 * 129 + 64];
    float* Ks = sm;
    float* Vs = sm + 4096;
    const int t = threadIdx.x, qi = t & 63, map = t >> 6;
    const int qb = blockIdx.x, h = blockIdx.y, b = blockIdx.z;
    const size_t m = (size_t)b * L + qb * 64 + qi;
    float q[64], o[128];
#pragma unroll
    for (int d = 0; d < 64; ++d) q[d] = bf2f(Q[m * 512 + h * 128 + map * 64 + d]);
#pragma unroll
    for (int e = 0; e < 128; ++e) o[e] = 0.f;
    float mx = -1e30f, l = 0.f;
    for (int kt = 0; kt < LT / 32; ++kt) {
        __syncthreads();
        for (int i = t; i < 32 * 128; i += 128) {
            const int kk = i >> 7, cc = i & 127; const size_t r = (size_t)b * LT + kt * 32 + kk;
            Ks[i] = bf2f(Kb[r * 512 + h * 128 + cc]); Vs[i] = bf2f(Vb[r * 512 + h * 128 + cc]);
        }
        __syncthreads();
#pragma unroll 1
        for (int k8 = 0; k8 < 32; k8 += 8) {
            float s[8]; float tm = mx;
#pragma unroll
            for (int kk = 0; kk < 8; ++kk) {
                const float* kr = Ks + (k8 + kk) * 128 + map * 64; float a = 0.f;
#pragma unroll
                for (int d = 0; d < 64; ++d) a += q[d] * kr[d];
                s[kk] = a; tm = fmaxf(tm, a);
            }
            const float scale = __expf(mx - tm); mx = tm; l *= scale;
#pragma unroll
            for (int e = 0; e < 128; ++e) o[e] *= scale;
#pragma unroll
            for (int kk = 0; kk < 8; ++kk) {
                const float p = __expf(s[kk] - mx); l += p; const float* vr = Vs + (k8 + kk) * 128;
#pragma unroll
                for (int e = 0; e < 128; ++e) o[e] += p * vr[e];
            }
        }
    }
    const float il = 1.f / l;
    __syncthreads();
    float* Ex = sm;
    if (map == 1) {
#pragma unroll
        for (int e = 0; e < 128; ++e) Ex[qi * 129 + e] = o[e] * il;
    }
    __syncthreads();
    if (map == 0) {
        const float lam = mod[3 * 6144]; float ss = 0.f;
#pragma unroll
        for (int e = 0; e < 128; ++e) { o[e] = o[e] * il - lam * Ex[qi * 129 + e]; ss += o[e] * o[e]; }
        const float rinv = rsqrtf(ss * (1.f / 128.f) + EPS) * 0.8f;
#pragma unroll
        for (int e = 0; e < 128; ++e) CAT[m * 1024 + h * 128 + e] = f2bf(o[e] * rinv * subg[e]);
    }
}

__global__ __launch_bounds__(128) void k_gdn_conv(const bf16_t* GQKV, const float* conv_w, bf16_t* KQV) {
    __shared__ float red[2];
    const int r = blockIdx.x, seg = blockIdx.y, t = threadIdx.x, c = seg * 128 + t;
    const int j = r % LT;
    const bool has_prev = !(j == 0 || j == LC), has_next = !(j == LC - 1 || j == LT - 1);
    const float xm = has_prev ? bf2f(GQKV[(size_t)(r - 1) * 1536 + c]) : 0.f;
    const float x0 = bf2f(GQKV[(size_t)r * 1536 + c]);
    const float xp = has_next ? bf2f(GQKV[(size_t)(r + 1) * 1536 + c]) : 0.f;
    float y = siluf(conv_w[c] * xm + conv_w[1536 + c] * x0 + conv_w[2 * 1536 + c] * xp);
    if (seg < 8) {
        float ss = wave_sum(y * y);
        if ((t & 63) == 0) red[t >> 6] = ss;
        __syncthreads();
        ss = red[0] + red[1];
        y *= rsqrtf(ss + EPS);
        if (seg < 4) y *= 0.08838834764831845f;
    }
    KQV[(size_t)r * 1536 + c] = f2bf(y);
}
__global__ __launch_bounds__(256) void k_gdn_gates(const float* AB, const float* a_log, const float* dt_bias, float* G, float* BETA) {
    const int gid = blockIdx.x * 256 + threadIdx.x; if (gid >= R * 8) return;
    const int r = gid >> 3, d = (gid >> 2) & 1, h = gid & 3;
    const float xa = AB[(size_t)r * 16 + d * 4 + h] + dt_bias[d * 4 + h];
    const float sp = fmaxf(xa, 0.f) + log1pf(expf(-fabsf(xa)));
    G[((size_t)d * R + r) * 4 + h] = -expf(a_log[d * 4 + h]) * sp;
    const float xb = AB[(size_t)r * 16 + 8 + d * 4 + h];
    BETA[((size_t)d * R + r) * 4 + h] = 1.f / (1.f + expf(-xb));
}
__device__ __forceinline__ int gdn_row(int d, int b, int cs, int i) {
    const bool isctx = cs < 4; const int n = isctx ? cs : cs - 4; const int len = isctx ? LC : L; const int base = b * LT + (isctx ? 0 : LC);
    const int p = n * 64 + i; return base + (d == 0 ? p : len - 1 - p);
}
__global__ __launch_bounds__(256) void k_gdn_prep(const bf16_t* KQV, const float* G, const float* BETA, bf16_t* WUB, bf16_t* AQK, float* GCUM) {
    extern __shared__ float sm[];
    float* ks = sm;
    float* qs = ks + 64 * 129;
    float* Am = qs + 64 * 129;
    float* sol = Am + 64 * 65;
    float* gc = sol + 64 * 256;
    float* be = gc + 64;
    const int ci = blockIdx.x, t = threadIdx.x;
    const int cs = ci % NCH, h = (ci / NCH) & 3, b = (ci / (NCH * 4)) % NB, d = ci / (NCH * 4 * NB);
    for (int i = t; i < 64 * 128; i += 256) {
        const int ii = i >> 7, cc = i & 127; const size_t r = gdn_row(d, b, cs, ii);
        qs[ii * 129 + cc] = bf2f(KQV[r * 1536 + h * 128 + cc]);
        ks[ii * 129 + cc] = bf2f(KQV[r * 1536 + 512 + h * 128 + cc]);
    }
    if (t < 64) { const size_t r = gdn_row(d, b, cs, t); be[t] = BETA[((size_t)d * R + r) * 4 + h]; gc[t] = G[((size_t)d * R + r) * 4 + h]; }
    __syncthreads();
    if (t == 0) { float a = 0.f; for (int i = 0; i < 64; ++i) { a += gc[i]; gc[i] = a; } }
    __syncthreads();
    if (t < 64) GCUM[(size_t)ci * 64 + t] = gc[t];
    for (int i = t; i < 64 * 256; i += 256) {
        const int ii = i >> 8, cc = i & 255; const size_t r = gdn_row(d, b, cs, ii);
        float v;
        if (cc < 128) v = be[ii] * __expf(gc[ii]) * ks[ii * 129 + cc];
        else v = be[ii] * bf2f(KQV[r * 1536 + 1024 + h * 128 + (cc - 128)]);
        sol[ii * 256 + cc] = v;
    }
    for (int e = t; e < 64 * 64; e += 256) {
        const int i = e >> 6, j = e & 63;
        float kk = 0.f, qk = 0.f;
        if (j <= i) {
            for (int dd = 0; dd < 128; ++dd) { const float kj = ks[j * 129 + dd]; kk += ks[i * 129 + dd] * kj; qk += qs[i * 129 + dd] * kj; }
        }
        const float dec = (j <= i) ? __expf(gc[i] - gc[j]) : 0.f;
        Am[i * 65 + j] = (j < i) ? be[i] * kk * dec : 0.f;
        AQK[(size_t)ci * 4096 + e] = f2bf((j <= i) ? qk * dec : 0.f);
    }
    __syncthreads();
    for (int i = 1; i < 64; ++i) {
        float a = sol[i * 256 + t];
        for (int j = 0; j < i; ++j) a -= Am[i * 65 + j] * sol[j * 256 + t];
        sol[i * 256 + t] = a;
    }
    __syncthreads();
    for (int i = t; i < 64 * 256; i += 256) WUB[(size_t)ci * 16384 + i] = f2bf(sol[i]);
}
__global__ __launch_bounds__(256) void k_gdn_scan(const bf16_t* KQV, const bf16_t* WUB, const bf16_t* AQK, const float* GCUM, float* OGDN) {
    extern __shared__ float sm[];
    float* S = sm;
    float* ws = S + 128 * 32;
    float* kds = ws + 64 * 128;
    float* qds = kds + 64 * 128;
    float* aq = qds + 64 * 128;
    float* us = aq + 64 * 64;
    float* gcs = us + 64 * 32;
    const int t = threadIdx.x, c = t & 31, rg = t >> 5;
    const int sl = blockIdx.x & 3, h = (blockIdx.x >> 2) & 3, b = (blockIdx.x >> 4) & 1, d = blockIdx.x >> 5;
    for (int i = t; i < 128 * 32; i += 256) S[i] = 0.f;
    for (int cs = 0; cs < NCH; ++cs) {
        const int ci = ((d * NB + b) * 4 + h) * NCH + cs;
        const bool lat = cs >= 4;
        __syncthreads();
        if (t < 64) gcs[t] = GCUM[(size_t)ci * 64 + t];
        __syncthreads();
        const float glast = gcs[63];
        for (int i = t; i < 64 * 128; i += 256) {
            const int ii = i >> 7, cc = i & 127; const size_t r = gdn_row(d, b, cs, ii);
            ws[i] = bf2f(WUB[(size_t)ci * 16384 + ii * 256 + cc]);
            kds[i] = bf2f(KQV[r * 1536 + 512 + h * 128 + cc]) * __expf(glast - gcs[ii]);
            if (lat) qds[i] = bf2f(KQV[r * 1536 + h * 128 + cc]) * __expf(gcs[ii]);
        }
        if (lat) for (int i = t; i < 64 * 64; i += 256) aq[i] = bf2f(AQK[(size_t)ci * 4096 + i]);
        __syncthreads();
        float u[8];
#pragma unroll
        for (int i = 0; i < 8; ++i) u[i] = bf2f(WUB[(size_t)ci * 16384 + (rg * 8 + i) * 256 + 128 + sl * 32 + c]);
        for (int dd = 0; dd < 128; ++dd) {
            const float sv = S[dd * 32 + c];
#pragma unroll
            for (int i = 0; i < 8; ++i) u[i] -= ws[(rg * 8 + i) * 128 + dd] * sv;
        }
#pragma unroll
        for (int i = 0; i < 8; ++i) us[(rg * 8 + i) * 32 + c] = u[i];
        float o[8];
        if (lat) {
#pragma unroll
            for (int i = 0; i < 8; ++i) o[i] = 0.f;
            for (int dd = 0; dd < 128; ++dd) {
                const float sv = S[dd * 32 + c];
#pragma unroll
                for (int i = 0; i < 8; ++i) o[i] += qds[(rg * 8 + i) * 128 + dd] * sv;
            }
        }
        __syncthreads();
        if (lat) {
            for (int j = 0; j < 64; ++j) {
                const float uv = us[j * 32 + c];
#pragma unroll
                for (int i = 0; i < 8; ++i) o[i] += aq[(rg * 8 + i) * 64 + j] * uv;
            }
#pragma unroll
            for (int i = 0; i < 8; ++i) {
                const int r = gdn_row(d, b, cs, rg * 8 + i); const int jj = r % LT; const size_t m = (size_t)b * L + (jj - LC);
                OGDN[((size_t)d * M + m) * 512 + h * 128 + sl * 32 + c] = o[i];
            }
        }
        const float gl = __expf(glast);
        float sn[16];
#pragma unroll
        for (int i = 0; i < 16; ++i) sn[i] = gl * S[(rg * 16 + i) * 32 + c];
        for (int j = 0; j < 64; ++j) {
            const float uv = us[j * 32 + c];
#pragma unroll
            for (int i = 0; i < 16; ++i) sn[i] += kds[j * 128 + rg * 16 + i] * uv;
        }
#pragma unroll
        for (int i = 0; i < 16; ++i) S[(rg * 16 + i) * 32 + c] = sn[i];
    }
}
__global__ __launch_bounds__(256) void k_gdn_out(const float* OGDN, const bf16_t* GATE, const float* gng, bf16_t* CAT) {
    const int lane = threadIdx.x & 63; const size_t wid = (size_t)blockIdx.x * 4 + (threadIdx.x >> 6);
    if (wid >= (size_t)M * 4) return;
    const size_t m = wid >> 2; const int h = (int)(wid & 3);
    const size_t off = m * 512 + h * 128 + lane * 2;
    const float2 a = *(const float2*)(OGDN + off), bq = *(const float2*)(OGDN + (size_t)M * 512 + off);
    const float o0 = a.x + bq.x, o1 = a.y + bq.y;
    const float ss = wave_sum(o0 * o0 + o1 * o1);
    const float rinv = rsqrtf(ss * (1.f / 128.f) + EPS);
    const float g0 = bf2f(GATE[off]), g1 = bf2f(GATE[off + 1]);
    CAT[m * 1024 + 512 + h * 128 + lane * 2] = f2bf(o0 * rinv * gng[lane * 2] * siluf(g0));
    CAT[m * 1024 + 512 + h * 128 + lane * 2 + 1] = f2bf(o1 * rinv * gng[lane * 2 + 1] * siluf(g1));
}

__global__ __launch_bounds__(1024) void k_topk(const float* aff, int* IDXL, float* GATEL, int* SLOT) {
    __shared__ unsigned hist[256];
    __shared__ unsigned sh_prefix, sh_need;
    __shared__ unsigned wsum[16], wsum2[16];
    const int e = blockIdx.x, b = blockIdx.y, t = threadIdx.x, lane = t & 63, w = t >> 6;
    unsigned key[8];
#pragma unroll
    for (int i = 0; i < 8; ++i) key[i] = __float_as_uint(aff[((size_t)b * L + t * 8 + i) * 16 + e]);
    unsigned prefix = 0, need = 1024;
    for (int pass = 0; pass < 4; ++pass) {
        const int shift = 24 - 8 * pass;
        if (t < 256) hist[t] = 0;
        __syncthreads();
        const unsigned himask = pass == 0 ? 0u : (0xffffffffu << (shift + 8));
#pragma unroll
        for (int i = 0; i < 8; ++i) if ((key[i] & himask) == prefix) atomicAdd(&hist[(key[i] >> shift) & 255], 1u);
        __syncthreads();
        if (t == 0) {
            unsigned cum = 0; int bsel = 0;
            for (int bin = 255; bin >= 0; --bin) { if (cum + hist[bin] >= need) { bsel = bin; break; } cum += hist[bin]; }
            sh_prefix = prefix | ((unsigned)bsel << shift); sh_need = need - cum;
        }
        __syncthreads();
        prefix = sh_prefix; need = sh_need;
        __syncthreads();
    }
    const unsigned thr = prefix;
    unsigned ngt = 0, neq = 0;
#pragma unroll
    for (int i = 0; i < 8; ++i) { ngt += key[i] > thr; neq += key[i] == thr; }
    unsigned sg = ngt, se = neq;
#pragma unroll
    for (int o = 1; o < 64; o <<= 1) { const unsigned a = __shfl_up(sg, o), c2 = __shfl_up(se, o); if (lane >= o) { sg += a; se += c2; } }
    if (lane == 63) { wsum[w] = sg; wsum2[w] = se; }
    __syncthreads();
    unsigned og = 0, oe = 0;
    for (int i = 0; i < w; ++i) { og += wsum[i]; oe += wsum2[i]; }
    unsigned total_gt = 0;
    for (int i = 0; i < 16; ++i) total_gt += wsum[i];
    unsigned pg = og + sg - ngt, pe = oe + se - neq;
    const int grp = b * 16 + e;
#pragma unroll
    for (int i = 0; i < 8; ++i) {
        const int tok = t * 8 + i; int slot = -1;
        if (key[i] > thr) { slot = (int)pg; ++pg; }
        else if (key[i] == thr) { if (pe < need) slot = (int)(total_gt + pe); ++pe; }
        SLOT[((size_t)b * L + tok) * 16 + e] = slot;
        if (slot >= 0) { IDXL[grp * 1024 + slot] = tok; GATEL[grp * 1024 + slot] = __uint_as_float(key[i]); }
    }
}

__global__ __launch_bounds__(256) void k_final(float* xio, const bf16_t* YE, const int* SLOT, const float* mod, const float* fg) {
    const int lane = threadIdx.x & 63; const int row = blockIdx.x * 4 + (threadIdx.x >> 6);
    if (row >= M) return;
    const int b = row / L;
    float acc[16];
#pragma unroll
    for (int i = 0; i < 16; ++i) acc[i] = 0.f;
    for (int e = 0; e < 16; ++e) {
        const int slot = SLOT[(size_t)row * 16 + e];
        if (slot >= 0) {
            const bf16_t* yr = YE + ((size_t)(b * 16 + e) * 1024 + slot) * 1024;
#pragma unroll
            for (int j = 0; j < 4; ++j) { const ushort4 v = *(const ushort4*)(yr + 4 * lane + 256 * j);
                acc[4 * j] += bf2f(v.x); acc[4 * j + 1] += bf2f(v.y); acc[4 * j + 2] += bf2f(v.z); acc[4 * j + 3] += bf2f(v.w); }
        }
    }
    const float* gt2 = mod + b * 6144 + 5120;
    float y[16]; float ss = 0.f;
#pragma unroll
    for (int j = 0; j < 4; ++j) {
        const int k0 = 4 * lane + 256 * j;
        const float4 xv = *(const float4*)(xio + (size_t)row * D + k0), gg = *(const float4*)(gt2 + k0);
        y[4 * j] = xv.x + gg.x * acc[4 * j]; y[4 * j + 1] = xv.y + gg.y * acc[4 * j + 1]; y[4 * j + 2] = xv.z + gg.z * acc[4 * j + 2]; y[4 * j + 3] = xv.w + gg.w * acc[4 * j + 3];
        ss += y[4 * j] * y[4 * j] + y[4 * j + 1] * y[4 * j + 1] + y[4 * j + 2] * y[4 * j + 2] + y[4 * j + 3] * y[4 * j + 3];
    }
    ss = wave_sum(ss);
    const float rinv = rsqrtf(ss * (1.f / D) + EPS);
#pragma unroll
    for (int j = 0; j < 4; ++j) {
        const int k0 = 4 * lane + 256 * j; const float4 gg = *(const float4*)(fg + k0);
        float4 o; o.x = y[4 * j] * rinv * gg.x; o.y = y[4 * j + 1] * rinv * gg.y; o.z = y[4 * j + 2] * rinv * gg.z; o.w = y[4 * j + 3] * rinv * gg.w;
        *(float4*)(xio + (size_t)row * D + k0) = o;
    }
}

extern "C" void kernel_launch(void* const* d_in, const int* in_sizes, int n_in, void* d_out, int out_size, void* d_ws, size_t ws_size, hipStream_t stream) {
    if (n_in != 24 || out_size != M * D || ws_size < WS_END) { fprintf(stderr, "kernel_launch: unexpected sizes n_in %d out %d ws %zu\n", n_in, out_size, ws_size); return; }
    const float* x = (const float*)d_in[0]; const float* c = (const float*)d_in[1]; const float* ctx = (const float*)d_in[2]; const float* c_ctx = (const float*)d_in[3];
    const float* w_mod = (const float*)d_in[4]; const float* b_mod = (const float*)d_in[5]; const float* norm1_g = (const float*)d_in[6]; const float* w_in = (const float*)d_in[7];
    const float* conv_w = (const float*)d_in[8]; const float* a_log = (const float*)d_in[9]; const float* dt_bias = (const float*)d_in[10]; const float* gdn_norm_g = (const float*)d_in[11];
    const float* lq1 = (const float*)d_in[12]; const float* lk1 = (const float*)d_in[13]; const float* lq2 = (const float*)d_in[14]; const float* lk2 = (const float*)d_in[15];
    const float* subg = (const float*)d_in[16]; const float* w_out = (const float*)d_in[17]; const float* norm2_g = (const float*)d_in[18]; const float* w_router = (const float*)d_in[19];
    const float* w_gate = (const float*)d_in[20]; const float* w_up = (const float*)d_in[21]; const float* w_down = (const float*)d_in[22]; const float* final_g = (const float*)d_in[23];
    char* ws = (char*)d_ws; float* out = (float*)d_out;
    float* MOD = (float*)(ws + WS_MOD); float* AFF = (float*)(ws + WS_AFF); int* SLOT = (int*)(ws + WS_SLOT); int* IDXL = (int*)(ws + WS_IDXL); float* GATEL = (float*)(ws + WS_GATEL);
    float* G = (float*)(ws + WS_G); float* BETA = (float*)(ws + WS_BETA); float* GCUM = (float*)(ws + WS_GCUM); float* AB = (float*)(ws + WS_AB);
    bf16_t* H1 = (bf16_t*)(ws + WS_H1); bf16_t* CAT = H1; bf16_t* H2 = H1;
    bf16_t* Qb = (bf16_t*)(ws + WS_Q); bf16_t* Kb = (bf16_t*)(ws + WS_K); bf16_t* Vb = (bf16_t*)(ws + WS_V); bf16_t* GQKV = (bf16_t*)(ws + WS_GQKV); bf16_t* GATE = (bf16_t*)(ws + WS_GATE);
    bf16_t* KQV = (bf16_t*)(ws + WS_KQV); bf16_t* WUB = (bf16_t*)(ws + WS_WUB); bf16_t* AQK = (bf16_t*)(ws + WS_AQK); bf16_t* HID = (bf16_t*)(ws + WS_HID); bf16_t* YE = (bf16_t*)(ws + WS_YE);
    float* OGDN = out;

    k_mod<<<24, 256, 0, stream>>>(c, c_ctx, w_mod, b_mod, lq1, lk1, lq2, lk2, MOD);
    k_norm<0><<<R / 4, 256, 0, stream>>>(x, ctx, norm1_g, MOD, H1, nullptr, nullptr);
    { EpiIn e{Qb, Kb, Vb, GQKV, GATE, AB};
      k_gemm<0, false, EpiIn><<<dim3((INC + 63) / 64, R / 64, 1), 256, 0, stream>>>(H1, nullptr, w_in, nullptr, 0, R, INC, D, e); }
    k_rope<<<(unsigned)(((size_t)M * 512) / 256), 256, 0, stream>>>(Qb, Kb);
    k_gdn_conv<<<dim3(R, 12), 128, 0, stream>>>(GQKV, conv_w, KQV);
    k_gdn_gates<<<(R * 8 + 255) / 256, 256, 0, stream>>>(AB, a_log, dt_bias, G, BETA);
    {
        static bool attr = false;
        const int prep_lds = (64 * 129 * 2 + 64 * 65 + 64 * 256 + 128) * 4, scan_lds = (128 * 32 + 3 * 64 * 128 + 64 * 64 + 64 * 32 + 64) * 4;
        if (!attr) { hipFuncSetAttribute((const void*)k_gdn_prep, hipFuncAttributeMaxDynamicSharedMemorySize, prep_lds);
                     hipFuncSetAttribute((const void*)k_gdn_scan, hipFuncAttributeMaxDynamicSharedMemorySize, scan_lds); attr = true; }
        k_gdn_prep<<<NCI, 256, prep_lds, stream>>>(KQV, G, BETA, WUB, AQK, GCUM);
        k_gdn_scan<<<64, 256, scan_lds, stream>>>(KQV, WUB, AQK, GCUM, OGDN);
    }
    k_attn<<<dim3(L / 64, 4, NB), 128, 0, stream>>>(Qb, Kb, Vb, MOD, subg, CAT);
    k_gdn_out<<<M, 256, 0, stream>>>(OGDN, GATE, gdn_norm_g, CAT);
    { EpiOut e{x, MOD, out};
      k_gemm<0, false, EpiOut><<<dim3(D / 64, M / 64, 1), 256, 0, stream>>>(CAT, nullptr, w_out, nullptr, 0, M, D, D, e); }
    k_norm<1><<<M / 4, 256, 0, stream>>>(out, nullptr, norm2_g, MOD, H2, w_router, AFF);
    k_topk<<<dim3(16, NB), 1024, 0, stream>>>(AFF, IDXL, GATEL, SLOT);
    { EpiUp e{HID};
      k_gemm<1, true, EpiUp><<<dim3(1024 / 64, 1024 / 64, 32), 256, 0, stream>>>(H2, IDXL, w_gate, w_up, (size_t)1024 * 1024, 1024, 1024, D, e); }
    { EpiDown e{YE, GATEL};
      k_gemm<0, false, EpiDown><<<dim3(1024 / 64, 1024 / 64, 32), 256, 0, stream>>>(HID, nullptr, w_down, nullptr, (size_t)1024 * 1024, 1024, 1024, 1024, e); }
    k_final<<<M / 4, 256, 0, stream>>>(out, YE, SLOT, MOD, final_g);
}
```

```cpp
#include <hip/hip_runtime.h>
#include <stdint.h>
#include <stdio.h>

typedef unsigned short bf16_t;
constexpr int D = 1024, NB = 2, L = 8192, LC = 256, LT = L + LC, R = NB * LT, M = NB * L;
constexpr int INC = 3600;
constexpr int NCH = LT / 64;
constexpr int NCI = 2 * NB * 4 * NCH;
constexpr float EPS = 1e-6f;
constexpr size_t MiB = 1u << 20;
constexpr int NT = 512;
constexpr size_t WS_CTL = 0, CTL_BYTES = 64 * 1024;
constexpr size_t WS_MOD = 128 * 1024;
constexpr size_t WS_ROPE = 256 * 1024;
constexpr size_t WS_WOUT_T = 1 * MiB;
constexpr size_t WS_AFF = 1 * MiB;
constexpr size_t WS_SLOT = 2 * MiB;
constexpr size_t WS_IDXL = 3 * MiB;
constexpr size_t WS_GATEL = 3 * MiB + 256 * 1024;
constexpr size_t WS_G = 4 * MiB;
constexpr size_t WS_BETA = 5 * MiB;
constexpr size_t WS_GL = 6 * MiB;
constexpr size_t WS_AB = 7 * MiB;
constexpr size_t WS_H1 = 10 * MiB;
constexpr size_t WS_WN = 10 * MiB;
constexpr size_t WS_QG = 43 * MiB;
constexpr size_t WS_K = 75 * MiB;
constexpr size_t WS_V = 92 * MiB;
constexpr size_t WS_GQKV = 109 * MiB;
constexpr size_t WS_QD = 159 * MiB;
constexpr size_t WS_AQK = 192 * MiB;
constexpr size_t WS_UB = 209 * MiB;
constexpr size_t WS_KDT = 242 * MiB;
constexpr size_t WS_WIN_T = 292 * MiB;
constexpr size_t WS_PO0 = 109 * MiB, WS_PO1 = 125 * MiB, WS_PO2 = 141 * MiB, WS_PO3 = 275 * MiB;
constexpr size_t WS_ML = 291 * MiB;
constexpr size_t WS_WD = 10 * MiB;
constexpr size_t WS_H2 = 43 * MiB;
constexpr size_t WS_XE = 75 * MiB;
constexpr size_t WS_YE = 75 * MiB;
constexpr size_t WS_HID = 139 * MiB;
constexpr size_t WS_WGU = 209 * MiB;
constexpr size_t WS_END = 299 * MiB;
constexpr int LDS_BYTES = 160 * 1024;
constexpr int LDS_MISC = LDS_BYTES - 256;

#define LAS __attribute__((address_space(3)))
__device__ __forceinline__ bf16_t f2bf(float f) { unsigned u = __float_as_uint(f); u += 0x7fffu + ((u >> 16) & 1u); return (bf16_t)(u >> 16); }
__device__ __forceinline__ float bf2f(bf16_t h) { return __uint_as_float(((unsigned)h) << 16); }
__device__ __forceinline__ float siluf(float x) { return x * __builtin_amdgcn_rcpf(1.f + __expf(-x)); }
__device__ __forceinline__ float wave_sum(float v) {
#pragma unroll
    for (int o = 1; o < 64; o <<= 1) v += __shfl_xor(v, o);
    return v;
}

typedef float f32x4 __attribute__((ext_vector_type(4)));
typedef float f32x2_cv __attribute__((ext_vector_type(2))); typedef __bf16 bf16x2_cv __attribute__((ext_vector_type(2)));
__device__ __forceinline__ unsigned cvt2bf(float lo, float hi) { f32x2_cv v = {lo, hi}; bf16x2_cv b = __builtin_convertvector(v, bf16x2_cv); return __builtin_bit_cast(unsigned, b); }
__device__ __forceinline__ int tid_fresh() { int t = threadIdx.x; asm volatile("" : "+v"(t)); return t; }
#define XB_TMO      128
#define XB_XCNT(j)  (256  + 64 * (j))
#define XB_XSUB(j)  (1280 + 64 * (j))
#define XB_XGEN(j)  (2304 + 64 * (j))
#define XB_TOP      3328
#define XB_TOPGEN   3392
#define XCD_BAR_WORDS 3456
#define XB_SPIN_CAP (1u << 22)
__device__ __forceinline__ unsigned xb_ld(unsigned* p)              { return __hip_atomic_load(p, __ATOMIC_RELAXED, __HIP_MEMORY_SCOPE_AGENT); }
__device__ __forceinline__ unsigned xb_add(unsigned* p, unsigned v) { return __hip_atomic_fetch_add(p, v, __ATOMIC_RELAXED, __HIP_MEMORY_SCOPE_AGENT); }
__device__ __forceinline__ unsigned xb_xcc_id() { return (unsigned)__builtin_amdgcn_s_getreg((3 << 11) | 20) & 0xFu; }
#define XB_SPIN(cond, bar) do { unsigned _sp = 0; while (cond) { __builtin_amdgcn_s_sleep(1); \
    if ((++_sp & 255u) == 0u) { if (xb_ld(&(bar)[XB_TMO])) break; if (_sp > XB_SPIN_CAP) { atomicAdd(&(bar)[XB_TMO], 1u); break; } } } } while (0)
struct XcdBarrier { unsigned* bar; unsigned x; volatile LAS unsigned* st; };
__device__ __forceinline__ XcdBarrier xcd_barrier_post(unsigned* bar, volatile LAS unsigned* st) {
    XcdBarrier b; b.bar = bar; b.x = xb_xcc_id(); b.st = st;
    if (threadIdx.x == 0) (void)xb_add(&bar[XB_XCNT(b.x)], 1u);
    return b;
}
__device__ __forceinline__ void xcd_barrier_complete(unsigned* bar, unsigned x, unsigned& nloc, unsigned& nx) {
    const unsigned G = gridDim.x * gridDim.y * gridDim.z;
    unsigned sum, cnt, mine, sp = 0u;
    for (;;) {
        sum = 0u; cnt = 0u; mine = 0u;
#pragma unroll
        for (unsigned j = 0; j < 16; ++j) { const unsigned c = xb_ld(&bar[XB_XCNT(j)]); sum += c; cnt += (c > 0u) ? 1u : 0u; mine = (j == x) ? c : mine; }
        if (sum == G) break;
        __builtin_amdgcn_s_sleep(1);
        if ((++sp & 255u) == 0u) { if (xb_ld(&bar[XB_TMO])) break; if (sp > XB_SPIN_CAP) { atomicAdd(&bar[XB_TMO], 1u); break; } }
    }
    nloc = mine > 0u ? mine : 1u; nx = cnt > 0u ? cnt : 1u;
}
__device__ __forceinline__ void xcd_barrier(const XcdBarrier& b) {
    asm volatile("s_waitcnt vmcnt(0)" ::: "memory");
    __syncthreads();
    if (threadIdx.x == 0) {
        unsigned* bar = b.bar;
        __builtin_amdgcn_s_waitcnt(0);
        unsigned nloc = b.st[0], nx = b.st[1];
        if (nloc == 0u) { xcd_barrier_complete(bar, b.x, nloc, nx); b.st[0] = nloc; b.st[1] = nx; }
        const unsigned old = xb_add(&bar[XB_XSUB(b.x)], 1u);
        const unsigned gen = old / nloc;
        if (old + 1u == (gen + 1u) * nloc) {
            __builtin_amdgcn_fence(__ATOMIC_RELEASE, "agent");
            asm volatile("s_waitcnt vmcnt(0)" ::: "memory");
            const unsigned og = xb_add(&bar[XB_TOP], 1u);
            const unsigned tg = og / nx;
            if (og + 1u == (tg + 1u) * nx) xb_add(&bar[XB_TOPGEN], 1u);
            else XB_SPIN(xb_ld(&bar[XB_TOPGEN]) == tg, bar);
            __builtin_amdgcn_fence(__ATOMIC_ACQUIRE, "agent");
            xb_add(&bar[XB_XGEN(b.x)], 1u);
            asm volatile("s_waitcnt vmcnt(0)" ::: "memory");
        } else {
            XB_SPIN(xb_ld(&bar[XB_XGEN(b.x)]) == gen, bar);
            __builtin_amdgcn_fence(__ATOMIC_ACQUIRE, "agent");
            asm volatile("s_waitcnt vmcnt(0)" ::: "memory");
        }
    }
    __syncthreads();
}

struct Args {
    const float *x, *c, *ctx, *c_ctx, *w_mod, *b_mod, *norm1_g, *w_in, *conv_w, *a_log, *dt_bias, *gdn_norm_g;
    const float *lq1, *lk1, *lq2, *lk2, *subg, *w_out, *norm2_g, *w_router, *w_gate, *w_up, *w_down, *final_g;
    float* out; unsigned char* ws;
};
typedef const __attribute__((address_space(4))) Args& ArgsRef;

__device__ __forceinline__ void ph_mod(ArgsRef a, float* lds) {
    const int tix_ = tid_fresh();
    float* s = lds;
    float* red = lds + 3072;
    float* mod = (float*)(a.ws + WS_MOD);
    const int t = tix_;
    for (int i = t; i < 1024; i += NT) { s[i] = siluf(a.c[i]); s[1024 + i] = siluf(a.c[1024 + i]); s[2048 + i] = siluf(a.c_ctx[i]); }
    __syncthreads();
    const int rq = t & 7, kg = t >> 3;
    for (int it = blockIdx.x; it < 256; it += gridDim.x) {
        const int n0 = it * 24;
        f32x4 a0 = {0.f, 0.f, 0.f, 0.f}, a1 = a0, a2 = a0;
        if (rq < 6) {
            f32x4 wv[16];
#pragma unroll
            for (int j = 0; j < 16; ++j) wv[j] = *(const f32x4*)(a.w_mod + (size_t)(kg + 64 * j) * 6144 + n0 + 4 * rq);
#pragma unroll
            for (int j = 0; j < 16; ++j) { const int k = kg + 64 * j; a0 += wv[j] * s[k]; a1 += wv[j] * s[1024 + k]; a2 += wv[j] * s[2048 + k]; }
#pragma unroll
            for (int e = 0; e < 4; ++e) { red[(kg * 3 + 0) * 24 + 4 * rq + e] = a0[e]; red[(kg * 3 + 1) * 24 + 4 * rq + e] = a1[e]; red[(kg * 3 + 2) * 24 + 4 * rq + e] = a2[e]; }
        }
        __syncthreads();
        if (t < 72) {
            const int v = t / 24, cc = t % 24; float acc = a.b_mod[n0 + cc];
            for (int g = 0; g < 64; ++g) acc += red[(g * 3 + v) * 24 + cc];
            mod[v * 6144 + n0 + cc] = acc;
        }
        __syncthreads();
    }
    if (blockIdx.x == 0 && t == 0) {
        float s1 = 0.f, s2 = 0.f;
        for (int i = 0; i < 64; ++i) { s1 += a.lq1[i] * a.lk1[i]; s2 += a.lq2[i] * a.lk2[i]; }
        mod[3 * 6144] = expf(s1) - expf(s2) + 0.2f;
    }
}

template <int MODE>
__device__ __forceinline__ void ph_norm(ArgsRef a, float* lds) {
    const int tix_ = tid_fresh();
    {
        const float* wsrc0 = MODE == 0 ? a.w_in + 3584 : a.w_router; const int wld0 = MODE == 0 ? INC : 16;
        __syncthreads();
        for (int k = tix_; k < 1024; k += NT) {
            const float4* wr = (const float4*)(wsrc0 + (size_t)k * wld0);
            const float4 w0 = wr[0], w1 = wr[1], w2 = wr[2], w3 = wr[3];
            lds[0 * 1024 + k] = w0.x; lds[1 * 1024 + k] = w0.y; lds[2 * 1024 + k] = w0.z; lds[3 * 1024 + k] = w0.w;
            lds[4 * 1024 + k] = w1.x; lds[5 * 1024 + k] = w1.y; lds[6 * 1024 + k] = w1.z; lds[7 * 1024 + k] = w1.w;
            lds[8 * 1024 + k] = w2.x; lds[9 * 1024 + k] = w2.y; lds[10 * 1024 + k] = w2.z; lds[11 * 1024 + k] = w2.w;
            lds[12 * 1024 + k] = w3.x; lds[13 * 1024 + k] = w3.y; lds[14 * 1024 + k] = w3.z; lds[15 * 1024 + k] = w3.w;
        }
        __syncthreads();
    }
    const float* mod = (const float*)(a.ws + WS_MOD);
    bf16_t* out = (bf16_t*)(a.ws + (MODE == 0 ? WS_H1 : WS_H2));
    float* aff = (float*)(a.ws + WS_AFF);
    const float* g = MODE == 0 ? a.norm1_g : a.norm2_g;
    const int lane = tix_ & 63;
    const int nrows = MODE == 0 ? R : M;
    for (int row = blockIdx.x * 8 + (tix_ >> 6); row < nrows; row += gridDim.x * 8) {
        const float* src; int mv;
        if (MODE == 0) { const int b = row / LT, j = row % LT; if (j < LC) { src = a.ctx + ((size_t)b * LC + j) * D; mv = 2; } else { src = a.x + ((size_t)b * L + (j - LC)) * D; mv = b; } }
        else { src = a.out + (size_t)row * D; mv = row / L; }
        const float* sh = mod + mv * 6144 + (MODE == 0 ? 0 : 3072);
        const float* sc = sh + 1024;
        float4 v[4]; float ss = 0.f;
#pragma unroll
        for (int j = 0; j < 4; ++j) { v[j] = *(const float4*)(src + 4 * lane + 256 * j); ss += v[j].x * v[j].x + v[j].y * v[j].y + v[j].z * v[j].z + v[j].w * v[j].w; }
        ss = wave_sum(ss);
        const float rinv = rsqrtf(ss * (1.f / D) + EPS);
        float y[16];
#pragma unroll
        for (int j = 0; j < 4; ++j) {
            const int k0 = 4 * lane + 256 * j;
            const float4 gg = *(const float4*)(g + k0), s1 = *(const float4*)(sc + k0), s0 = *(const float4*)(sh + k0);
            y[4 * j + 0] = v[j].x * rinv * gg.x * (1.f + s1.x) + s0.x;
            y[4 * j + 1] = v[j].y * rinv * gg.y * (1.f + s1.y) + s0.y;
            y[4 * j + 2] = v[j].z * rinv * gg.z * (1.f + s1.z) + s0.z;
            y[4 * j + 3] = v[j].w * rinv * gg.w * (1.f + s1.w) + s0.w;
            ushort4 o; o.x = f2bf(y[4 * j + 0]); o.y = f2bf(y[4 * j + 1]); o.z = f2bf(y[4 * j + 2]); o.w = f2bf(y[4 * j + 3]);
            *(ushort4*)(out + (size_t)row * D + k0) = o;
        }
        {
            float lg[16];
#pragma unroll
            for (int e = 0; e < 16; ++e) {
                float acc = 0.f;
#pragma unroll
                for (int j = 0; j < 4; ++j) { const float4 w = *(const float4*)(lds + e * 1024 + 4 * lane + 256 * j);
                    acc += y[4 * j] * w.x + y[4 * j + 1] * w.y + y[4 * j + 2] * w.z + y[4 * j + 3] * w.w; }
                lg[e] = acc;
                if ((e & 3) == 3) asm volatile("" ::: "memory");
            }
            float v8[8], v4[4], v2[2], mine;
            { const bool up = lane & 32;
#pragma unroll
              for (int i = 0; i < 8; ++i) { const float keep = up ? lg[8 + i] : lg[i], send = up ? lg[i] : lg[8 + i]; v8[i] = keep + __shfl_xor(send, 32); } }
            { const bool up = lane & 16;
#pragma unroll
              for (int i = 0; i < 4; ++i) { const float keep = up ? v8[4 + i] : v8[i], send = up ? v8[i] : v8[4 + i]; v4[i] = keep + __shfl_xor(send, 16); } }
            { const bool up = lane & 8;
#pragma unroll
              for (int i = 0; i < 2; ++i) { const float keep = up ? v4[2 + i] : v4[i], send = up ? v4[i] : v4[2 + i]; v2[i] = keep + __shfl_xor(send, 8); } }
            { const bool up = lane & 4; const float keep = up ? v2[1] : v2[0], send = up ? v2[0] : v2[1]; mine = keep + __shfl_xor(send, 4); }
            mine += __shfl_xor(mine, 2); mine += __shfl_xor(mine, 1);
            const int ecol = ((lane >> 5) & 1) * 8 + ((lane >> 4) & 1) * 4 + ((lane >> 3) & 1) * 2 + ((lane >> 2) & 1);
            if (MODE == 0) {
                if ((lane & 3) == 0) ((float*)(a.ws + WS_AB))[(size_t)row * 16 + ecol] = mine;
            } else {
                float mx = mine;
                mx = fmaxf(mx, __shfl_xor(mx, 4)); mx = fmaxf(mx, __shfl_xor(mx, 8)); mx = fmaxf(mx, __shfl_xor(mx, 16)); mx = fmaxf(mx, __shfl_xor(mx, 32));
                const float ex = expf(mine - mx);
                float sum = ex;
                sum += __shfl_xor(sum, 4); sum += __shfl_xor(sum, 8); sum += __shfl_xor(sum, 16); sum += __shfl_xor(sum, 32);
                if ((lane & 3) == 0) aff[(size_t)row * 16 + ecol] = ex / sum;
            }
        }
    }
}

namespace pg8 {
#define PG8_LAS __attribute__((address_space(3)))
typedef unsigned short bf16_t;
typedef short bf16x8 __attribute__((ext_vector_type(8)));
typedef float f32x4 __attribute__((ext_vector_type(4)));
typedef unsigned u32x4 __attribute__((ext_vector_type(4)));
constexpr int BM = 256, BK = 64, HALF = 128, HTB = HALF * BK * 2  , STAGE_BYTES = 8 * HTB, NXCD = 8, WGM = 8;

__host__ __device__ __forceinline__ int lds_byte(int r, int c) { const int st = (r >> 4) * 2 + (c >> 5), rr = r & 15, cc = c & 31, ob = rr * 64 + cc * 2; return st * 1024 + (ob ^ (((ob >> 9) & 1) << 5)); }
__host__ __device__ __forceinline__ void stage_rc(int b, int& R, int& C) { const int st = b / 1024, sb = b % 1024, swz = sb ^ (((sb >> 9) & 1) << 5); R = (st >> 1) * 16 + swz / 64; C = (st & 1) * 32 + (swz % 64) / 2; }
__host__ __device__ __forceinline__ int perm32(int rho) { const int n = rho >> 4, i = rho & 15; return 8 * (i >> 2) + 4 * n + (i & 3); }

struct Unit { int pm, pn; };
struct Gemm { const bf16_t* A; const bf16_t* Bt; int M, N, K; int grp_tiles, grp_rows; const int* idx; int tpb; size_t bstride;
    __host__ __device__ __forceinline__ size_t boff(const Unit& u) const { return ((size_t)(grp_tiles ? ((u.pm / grp_tiles) & 15) * grp_rows : 0) + (size_t)u.pn * BM) * (size_t)K * 2; } };

struct StaticOrder {
    int nM, nN, nwg, G, c;
    __host__ __device__ void init(int M, int N, int G_, int c_) { nM = M / BM; nN = N / BM; nwg = nM * nN; G = G_; c = c_; }
    __host__ __device__ bool next(int i, Unit& u) const {
        const long L = (long)i * G + c; if (L >= nwg) return false;
        int wgid = (int)L; { const int q = nwg / NXCD, r = nwg % NXCD, xcd = wgid % NXCD, off = wgid / NXCD; wgid = (xcd < r ? xcd * (q + 1) : r * (q + 1) + (xcd - r) * q) + off; }
        const int nig = WGM * nN, gid = wgid / nig, fm = gid * WGM, gsz = (nM - fm) < WGM ? (nM - fm) : WGM;
        u.pm = fm + ((wgid % nig) % gsz); u.pn = (wgid % nig) / gsz; return true;
    }
    __device__ __forceinline__ void a_ready(const Unit&) const {}
    __device__ __forceinline__ void done(const Unit&) const {}
};

__device__ __forceinline__ unsigned cvt_pk_bf16(float lo, float hi) { return cvt2bf(lo, hi); }
typedef float f32x2 __attribute__((ext_vector_type(2)));

template <class Epi, class Sched, bool ALIGN_EPI = false, bool SP2 = false, bool GATHER = false>
__device__ __forceinline__ void gemm_phase(PG8_LAS unsigned char* lds, const Gemm g, const Sched& S, const Epi& E) {
    const int tid = tid_fresh(), wid = __builtin_amdgcn_readfirstlane(tid >> 6), lane = tid & 63, wr = wid >> 2, wc = wid & 3, fr = lane & 15, fq = lane >> 4;
    const int K = g.K, nt = K / BK;
    unsigned voffA[2], voffB[2];
#pragma unroll
    for (int i = 0; i < 2; ++i) { int R, C; stage_rc(tid * 16 + i * 8192, R, C); const int Rb = Epi::PERM ? ((R & ~31) + perm32(R & 31)) : R;
        voffA[i] = (unsigned)(R * K + C) * 2u; voffB[i] = (unsigned)(Rb * K + C) * 2u; }
    const size_t kstep = (size_t)(BK * 2);
    const size_t hstep = (size_t)HALF * K * 2;
    const size_t tstep = 2 * hstep;
    const unsigned ldsw = (unsigned)wid * 1024u;
    const int aoff = lds_byte(wr * 64 + fr, fq * 8), boff = lds_byte(wc * 32 + fr, fq * 8);
#define PG8_SA(b, h) (((b) * 2 + (h)) * HTB)
#define PG8_SB(b, h) ((4 + (b) * 2 + (h)) * HTB)
#define PG8_STAGE(bufoff, gbase, voff) do { _Pragma("unroll") for (int _i = 0; _i < 2; ++_i) \
        __builtin_amdgcn_global_load_lds((const unsigned*)((const char*)(gbase) + (voff)[_i]), (PG8_LAS unsigned*)(lds + (bufoff) + ldsw + _i * 8192), 16, 0, 0); } while (0)
#define PG8_LDA(dst, b, h) do { _Pragma("unroll") for (int m = 0; m < 4; ++m) _Pragma("unroll") for (int k = 0; k < 2; ++k) dst[m][k] = *(const PG8_LAS bf16x8*)(lds + PG8_SA(b, h) + aoff + m * 2048 + k * 1024); } while (0)
#define PG8_LDB(dst, b, h) do { _Pragma("unroll") for (int n = 0; n < 2; ++n) _Pragma("unroll") for (int k = 0; k < 2; ++k) dst[n][k] = *(const PG8_LAS bf16x8*)(lds + PG8_SB(b, h) + boff + n * 2048 + k * 1024); } while (0)
#define PG8_MMA(ai, bj, At, Bt) do { __builtin_amdgcn_s_setprio(1); _Pragma("unroll") for (int m = 0; m < 4; ++m) _Pragma("unroll") for (int n = 0; n < 2; ++n) _Pragma("unroll") for (int k = 0; k < 2; ++k) \
        acc[ai][bj][m][n] = __builtin_amdgcn_mfma_f32_16x16x32_bf16(Bt[n][k], At[m][k], acc[ai][bj][m][n], 0, 0, 0); __builtin_amdgcn_s_setprio(0); } while (0)
#define PG8_WAIT_V(n) asm volatile("s_waitcnt vmcnt(" #n ")" ::: "memory")
#define PG8_WAIT_L(n) asm volatile("s_waitcnt lgkmcnt(" #n ")" ::: "memory")
#define PG8_BAR __builtin_amdgcn_s_barrier()
#define PG8_SCHED __builtin_amdgcn_sched_barrier(0)
    Unit cur, nxt; int ui = 0;
    if (!S.next(0, cur)) return;
    f32x4 acc[2][2][4][2];
#pragma unroll
    for (int a = 0; a < 2; ++a)
#pragma unroll
        for (int b = 0; b < 2; ++b)
#pragma unroll
            for (int m = 0; m < 4; ++m)
#pragma unroll
                for (int n = 0; n < 2; ++n) acc[a][b][m][n] = (f32x4){0.f, 0.f, 0.f, 0.f};
    bf16x8 At[4][2], B0[2][2], B1[2][2];
    unsigned vA0[2], vA1[2], nvA0[2], nvA1[2];
    int rA[2], cA2[2];
#pragma unroll
    for (int i = 0; i < 2; ++i) { int R, C; stage_rc(tid * 16 + i * 8192, R, C); rA[i] = R; cA2[i] = C * 2; }
#define PG8_AOFF(u_, o0_, o1_) do { _Pragma("unroll") for (int i_ = 0; i_ < 2; ++i_) { \
        if (GATHER) { o0_[i_] = (unsigned)g.idx[(u_).pm * BM + rA[i_]] * (unsigned)(K * 2) + cA2[i_]; o1_[i_] = (unsigned)g.idx[(u_).pm * BM + HALF + rA[i_]] * (unsigned)(K * 2) + cA2[i_]; } \
        else { o0_[i_] = voffA[i_]; o1_[i_] = voffA[i_] + (unsigned)hstep; } } } while (0)
#define PG8_ABASE(u_) (GATHER ? (const char*)g.A + (size_t)((u_).pm / g.tpb) * g.bstride : (const char*)g.A + (size_t)(u_).pm * tstep)
    PG8_AOFF(cur, vA0, vA1);
    const char* cA = PG8_ABASE(cur); const char* cB = (const char*)g.Bt + g.boff(cur);
    S.a_ready(cur);
    if constexpr (SP2) {
        PG8_STAGE(PG8_SB(0, 0), cB, voffB); PG8_STAGE(PG8_SB(0, 1), cB + hstep, voffB); PG8_STAGE(PG8_SA(0, 0), cA, vA0); PG8_STAGE(PG8_SA(0, 1), cA, vA1);
        if (wr == 1) PG8_BAR;
        PG8_WAIT_V(2); PG8_BAR;
        PG8_STAGE(PG8_SB(1, 0), cB + kstep, voffB); PG8_STAGE(PG8_SA(1, 0), cA + kstep, vA0); PG8_STAGE(PG8_SB(1, 1), cB + hstep + kstep, voffB);
        PG8_WAIT_V(6); PG8_BAR;
    } else {
        PG8_STAGE(PG8_SB(0, 0), cB, voffB); PG8_STAGE(PG8_SA(0, 0), cA, vA0); PG8_STAGE(PG8_SB(0, 1), cB + hstep, voffB); PG8_STAGE(PG8_SA(0, 1), cA, vA1);
        if (wr == 1) PG8_BAR;
        PG8_WAIT_V(4); PG8_BAR;
        PG8_STAGE(PG8_SB(1, 0), cB + kstep, voffB); PG8_STAGE(PG8_SA(1, 0), cA + kstep, vA0); PG8_STAGE(PG8_SB(1, 1), cB + hstep + kstep, voffB);
        PG8_WAIT_V(6); PG8_BAR;
    }
    for (;;) {
        const bool has_next = S.next(ui + 1, nxt);
        const char* nA = has_next ? PG8_ABASE(nxt) : cA; const char* nB = has_next ? (const char*)g.Bt + g.boff(nxt) : cB;
        if (has_next) PG8_AOFF(nxt, nvA0, nvA1); else { nvA0[0] = vA0[0]; nvA0[1] = vA0[1]; nvA1[0] = vA1[0]; nvA1[1] = vA1[1]; }
        for (int t = 0; t < nt; t += 2) {
            const bool last = (t == nt - 2);
            const char* a1 = cA + (size_t)(t + 1) * kstep;
            const char* a2 = last ? nA : cA + (size_t)(t + 2) * kstep; const char* b2 = last ? nB : cB + (size_t)(t + 2) * kstep;
            const char* a3 = a2 + kstep; const char* b3 = b2 + kstep;
            unsigned sA0[2], sA1[2]; sA0[0] = last ? nvA0[0] : vA0[0]; sA0[1] = last ? nvA0[1] : vA0[1]; sA1[0] = last ? nvA1[0] : vA1[0]; sA1[1] = last ? nvA1[1] : vA1[1];
            if (last && has_next) S.a_ready(nxt);
            if constexpr (SP2) {
            PG8_LDB(B0, 0, 0); PG8_LDB(B1, 0, 1); PG8_SCHED; PG8_LDA(At, 0, 0); PG8_STAGE(PG8_SA(1, 1), a1, vA1);
            PG8_WAIT_V(8); PG8_WAIT_L(0); PG8_BAR; PG8_MMA(0, 0, At, B0); PG8_MMA(0, 1, At, B1); PG8_BAR; PG8_SCHED;
            PG8_LDA(At, 0, 1); PG8_STAGE(PG8_SB(0, 0), b2, voffB); PG8_STAGE(PG8_SB(0, 1), b2 + hstep, voffB); PG8_STAGE(PG8_SA(0, 0), a2, sA0);
            PG8_WAIT_V(8); PG8_WAIT_L(0); PG8_BAR; PG8_MMA(1, 0, At, B0); PG8_MMA(1, 1, At, B1); PG8_BAR; PG8_SCHED;
            PG8_LDB(B0, 1, 0); PG8_LDB(B1, 1, 1); PG8_SCHED; PG8_LDA(At, 1, 0); PG8_STAGE(PG8_SA(0, 1), a2, sA1);
            PG8_WAIT_V(8); PG8_WAIT_L(0); PG8_BAR; PG8_MMA(0, 0, At, B0); PG8_MMA(0, 1, At, B1); PG8_BAR; PG8_SCHED;
            PG8_LDA(At, 1, 1); PG8_STAGE(PG8_SB(1, 0), b3, voffB); PG8_STAGE(PG8_SB(1, 1), b3 + hstep, voffB); PG8_STAGE(PG8_SA(1, 0), a3, sA0);
            PG8_WAIT_V(8); PG8_WAIT_L(0); PG8_BAR; PG8_MMA(1, 0, At, B0); PG8_MMA(1, 1, At, B1); PG8_BAR; PG8_SCHED;
            } else {
            PG8_LDB(B0, 0, 0); PG8_SCHED; PG8_LDA(At, 0, 0); PG8_STAGE(PG8_SA(1, 1), a1, vA1);
            PG8_WAIT_L(8); PG8_BAR; PG8_WAIT_L(0); PG8_MMA(0, 0, At, B0); PG8_BAR; PG8_SCHED;
            PG8_LDB(B1, 0, 1); PG8_STAGE(PG8_SB(0, 0), b2, voffB);
            PG8_BAR; PG8_WAIT_L(0); PG8_MMA(0, 1, At, B1); PG8_BAR;
            PG8_LDA(At, 0, 1); PG8_STAGE(PG8_SA(0, 0), a2, sA0);
            PG8_BAR; PG8_WAIT_L(0); PG8_MMA(1, 0, At, B0); PG8_BAR; PG8_SCHED;
            PG8_STAGE(PG8_SB(0, 1), b2 + hstep, voffB);
            PG8_WAIT_V(6); PG8_BAR; PG8_MMA(1, 1, At, B1); PG8_BAR;
            PG8_LDB(B0, 1, 0); PG8_SCHED; PG8_LDA(At, 1, 0); PG8_STAGE(PG8_SA(0, 1), a2, sA1);
            PG8_WAIT_L(8); PG8_BAR; PG8_WAIT_L(0); PG8_MMA(0, 0, At, B0); PG8_BAR; PG8_SCHED;
            PG8_LDB(B1, 1, 1); PG8_STAGE(PG8_SB(1, 0), b3, voffB);
            PG8_BAR; PG8_WAIT_L(0); PG8_MMA(0, 1, At, B1); PG8_BAR;
            PG8_LDA(At, 1, 1); PG8_STAGE(PG8_SA(1, 0), a3, sA0);
            PG8_BAR; PG8_WAIT_L(0); PG8_MMA(1, 0, At, B0); PG8_BAR; PG8_SCHED;
            PG8_STAGE(PG8_SB(1, 1), b3 + hstep, voffB);
            PG8_WAIT_V(6); PG8_BAR; PG8_MMA(1, 1, At, B1); PG8_BAR;
            }
        }
        if constexpr (ALIGN_EPI) { if (wr == 0) PG8_BAR; }
        if constexpr (!Epi::AFTER_DRAIN) { E(acc, cur, wr, wc, fr, fq); S.done(cur); }
        if (!has_next) break;
#pragma unroll
        for (int a = 0; a < 2; ++a)
#pragma unroll
            for (int b = 0; b < 2; ++b)
#pragma unroll
                for (int m = 0; m < 4; ++m)
#pragma unroll
                    for (int n = 0; n < 2; ++n) acc[a][b][m][n] = (f32x4){0.f, 0.f, 0.f, 0.f};
        cur = nxt; cA = nA; cB = nB; ++ui; vA0[0] = nvA0[0]; vA0[1] = nvA0[1]; vA1[0] = nvA1[0]; vA1[1] = nvA1[1];
        if constexpr (ALIGN_EPI) { if (wr == 1) PG8_BAR; }
    }
    PG8_WAIT_V(0);
    if constexpr (!ALIGN_EPI) { if (wr == 0) PG8_BAR; }
    PG8_BAR;
    if constexpr (Epi::AFTER_DRAIN) { E.fused(acc, cur, wr, wc, fr, fq, lds, wid, lane); S.done(cur); }
#undef PG8_SA
#undef PG8_SB
#undef PG8_STAGE
#undef PG8_AOFF
#undef PG8_ABASE
#undef PG8_LDA
#undef PG8_LDB
#undef PG8_MMA
#undef PG8_WAIT_V
#undef PG8_WAIT_L
#undef PG8_BAR
#undef PG8_SCHED
}
}

using pg8::u32x4; using pg8::Unit;
typedef unsigned u32x2 __attribute__((ext_vector_type(2)));
struct EpiInProj {
    static constexpr bool PERM = true, AFTER_DRAIN = false;
    bf16_t *QG, *Kb, *Vb, *GQKV; const float* rope;
    __device__ __forceinline__ void operator()(const f32x4 (&acc)[2][2][4][2], const Unit& u, int wr, int wc, int fr, int fq) const {
        const int b = u.pm / 33; const bool isctx = (u.pm % 33) == 0; const int pn = u.pn;
        bf16_t* base; int ld, rowoff = 0, colt; bool do_rope = false; float sc = 1.f;
        if (pn < 2) { if (isctx) return; base = QG; ld = 1024; rowoff = 256 * (b + 1); colt = pn * 256; do_rope = true; sc = 0.125f * 1.4426950408889634f; }
        else if (pn < 4) { base = Kb; ld = 512; colt = (pn - 2) * 256; do_rope = !isctx; }
        else if (pn < 6) { base = Vb; ld = 512; colt = (pn - 4) * 256; }
        else if (pn < 12) { base = GQKV; ld = 1536; colt = (pn - 6) * 256; }
        else { if (isctx) return; base = QG; ld = 1024; rowoff = 256 * (b + 1); colt = 512 + (pn - 12) * 256; }
        const int col0 = colt + wc * 32 + 8 * fq;
        const float sgn = fq < 2 ? -1.f : 1.f;
#pragma unroll
        for (int ai = 0; ai < 2; ++ai)
#pragma unroll
            for (int m = 0; m < 4; ++m) {
                const int r = u.pm * 256 + ai * 128 + wr * 64 + m * 16 + fr;
                bf16_t* rowp = base + (size_t)(r - rowoff) * ld + col0;
                if (do_rope) {
                    const int tt = r - b * LT - LC; const int pos = (wc & 1) ? (tt & 63) : (tt >> 6);
                    const float4* tp = (const float4*)(rope + (pos * 16 + 8 * (fq & 1)) * 2);
                    const float4 t0 = tp[0], t1 = tp[1], t2 = tp[2], t3 = tp[3];
                    const float cs[8] = {t0.x, t0.z, t1.x, t1.z, t2.x, t2.z, t3.x, t3.z}, sn[8] = {t0.y, t0.w, t1.y, t1.w, t2.y, t2.w, t3.y, t3.w};
#pragma unroll
                    for (int bj = 0; bj < 2; ++bj) {
                        const f32x4 v0 = acc[ai][bj][m][0], v1 = acc[ai][bj][m][1];
                        const float xv[8] = {v0[0], v0[1], v0[2], v0[3], v1[0], v1[1], v1[2], v1[3]}; float y[8];
#pragma unroll
                        for (int i = 0; i < 8; ++i) { auto sw_ = __builtin_amdgcn_permlane32_swap(__float_as_uint(xv[i]), __float_as_uint(xv[i]), false, false);
                            const float o = __uint_as_float(fq < 2 ? sw_[1] : sw_[0]); y[i] = (xv[i] * cs[i] + sgn * o * sn[i]) * sc; }
                        u32x4 w; w.x = pg8::cvt_pk_bf16(y[0], y[1]); w.y = pg8::cvt_pk_bf16(y[2], y[3]); w.z = pg8::cvt_pk_bf16(y[4], y[5]); w.w = pg8::cvt_pk_bf16(y[6], y[7]);
                        *(u32x4*)(rowp + bj * 128) = w;
                    }
                } else {
#pragma unroll
                    for (int bj = 0; bj < 2; ++bj) {
                        const f32x4 v0 = acc[ai][bj][m][0], v1 = acc[ai][bj][m][1];
                        u32x4 w; w.x = pg8::cvt_pk_bf16(v0[0], v0[1]); w.y = pg8::cvt_pk_bf16(v0[2], v0[3]); w.z = pg8::cvt_pk_bf16(v1[0], v1[1]); w.w = pg8::cvt_pk_bf16(v1[2], v1[3]);
                        *(u32x4*)(rowp + bj * 128) = w;
                    }
                }
            }
    }
};
struct EpiOutProj {
    static constexpr bool PERM = false, AFTER_DRAIN = false;
    const float* x; const float* mod; float* xn;
    __device__ __forceinline__ void operator()(const f32x4 (&acc)[2][2][4][2], const Unit& u, int wr, int wc, int fr, int fq) const {
        const int b = u.pm / 32; const float* gt1 = mod + b * 6144 + 2048;
        const int col0 = u.pn * 256 + wc * 32 + 4 * fq;
#pragma unroll
        for (int ai = 0; ai < 2; ++ai)
#pragma unroll
            for (int m = 0; m < 4; ++m) {
                const size_t off = (size_t)(u.pm * 256 + ai * 128 + wr * 64 + m * 16 + fr) * D + col0;
#pragma unroll
                for (int bj = 0; bj < 2; ++bj)
#pragma unroll
                    for (int n = 0; n < 2; ++n) {
                        const int co = bj * 128 + n * 16;
                        const f32x4 xv = *(const f32x4*)(x + off + co), gv = *(const f32x4*)(gt1 + col0 + co);
                        *(f32x4*)(xn + off + co) = xv + gv * acc[ai][bj][m][n];
                    }
            }
    }
};
struct EpiMoeUp {
    static constexpr bool PERM = true, AFTER_DRAIN = false;
    bf16_t* hid;
    __device__ __forceinline__ void operator()(const f32x4 (&acc)[2][2][4][2], const Unit& u, int wr, int wc, int fr, int fq) const {
        const int col0 = u.pn * 128 + wc * 32 + 8 * fq;
#pragma unroll
        for (int ai = 0; ai < 2; ++ai)
#pragma unroll
            for (int m = 0; m < 4; ++m) {
                bf16_t* rowp = hid + (size_t)(u.pm * 256 + ai * 128 + wr * 64 + m * 16 + fr) * 1024 + col0;
                float y[8];
#pragma unroll
                for (int n = 0; n < 2; ++n)
#pragma unroll
                    for (int i = 0; i < 4; ++i) y[n * 4 + i] = siluf(acc[ai][0][m][n][i]) * acc[ai][1][m][n][i];
                u32x4 w; w.x = pg8::cvt_pk_bf16(y[0], y[1]); w.y = pg8::cvt_pk_bf16(y[2], y[3]); w.z = pg8::cvt_pk_bf16(y[4], y[5]); w.w = pg8::cvt_pk_bf16(y[6], y[7]);
                *(u32x4*)rowp = w;
            }
    }
};
struct EpiMoeDown {
    static constexpr bool PERM = true, AFTER_DRAIN = false;
    bf16_t* ye; const float* gatel;
    __device__ __forceinline__ void operator()(const f32x4 (&acc)[2][2][4][2], const Unit& u, int wr, int wc, int fr, int fq) const {
        const int col0 = u.pn * 256 + wc * 32 + 8 * fq;
#pragma unroll
        for (int ai = 0; ai < 2; ++ai)
#pragma unroll
            for (int m = 0; m < 4; ++m) {
                const int r = u.pm * 256 + ai * 128 + wr * 64 + m * 16 + fr; const float gv = gatel[r];
                bf16_t* rowp = ye + (size_t)r * 1024 + col0;
#pragma unroll
                for (int bj = 0; bj < 2; ++bj) {
                    const f32x4 v0 = acc[ai][bj][m][0] * gv, v1 = acc[ai][bj][m][1] * gv;
                    u32x4 w; w.x = pg8::cvt_pk_bf16(v0[0], v0[1]); w.y = pg8::cvt_pk_bf16(v0[2], v0[3]); w.z = pg8::cvt_pk_bf16(v1[0], v1[1]); w.w = pg8::cvt_pk_bf16(v1[2], v1[3]);
                    *(u32x4*)(rowp + bj * 128) = w;
                }
            }
    }
};

__device__ __forceinline__ unsigned pk2(float lo, float hi) { return (unsigned)f2bf(lo) | ((unsigned)f2bf(hi) << 16); }
__device__ __forceinline__ void transpose_item(const float* W, int ldw, int k0, int n0, bf16_t* WT, int K, int dst_row0, LAS float* scr, int lane) {
    {
        const int kq = lane >> 3, n4 = (lane & 7) * 4;
        f32x4 wv[8];
#pragma unroll
        for (int i = 0; i < 8; ++i) wv[i] = *(const f32x4*)(W + (size_t)(k0 + kq + 8 * i) * ldw + n0 + n4);
#pragma unroll
        for (int i = 0; i < 8; ++i) { LAS float* sp = scr + (kq + 8 * i) * 33 + n4; sp[0] = wv[i][0]; sp[1] = wv[i][1]; sp[2] = wv[i][2]; sp[3] = wv[i][3]; }
    }
    asm volatile("s_waitcnt lgkmcnt(0)" ::: "memory");
    const int c = lane & 7;
#pragma unroll
    for (int j = 0; j < 4; ++j) { const int n = (lane >> 3) + 8 * j; const LAS float* s = scr + (8 * c) * 33 + n;
        uint4 o; o.x = pk2(s[0 * 33], s[1 * 33]); o.y = pk2(s[2 * 33], s[3 * 33]); o.z = pk2(s[4 * 33], s[5 * 33]); o.w = pk2(s[6 * 33], s[7 * 33]);
        *(uint4*)(WT + (size_t)(dst_row0 + n) * K + k0 + 8 * c) = o; }
    asm volatile("s_waitcnt lgkmcnt(0)" ::: "memory");
}
__device__ __forceinline__ void ph_convert_small(ArgsRef a, unsigned char* lds_raw) {
    const int tix_ = tid_fresh();
    const int lane = tix_ & 63, wave = tix_ >> 6;
    LAS float* scr = (LAS float*)((LAS unsigned char*)lds_raw + wave * 16384);
    const int gw = blockIdx.x * 8 + wave, NGW = gridDim.x * 8;
    bf16_t* WinT = (bf16_t*)(a.ws + WS_WIN_T);
    constexpr int I_IN = 16 * 112;
    for (int it = gw; it < I_IN; it += NGW) { const int kb = it / 112, nb = it % 112; transpose_item(a.w_in, INC, 64 * kb, 32 * nb, WinT, 1024, 32 * nb, scr, lane); }
    float* rope = (float*)(a.ws + WS_ROPE);
    for (int i = blockIdx.x * NT + tix_; i < 128 * 16; i += gridDim.x * NT) {
        const int pos = i >> 4, j = i & 15;
        const float ang = (float)pos * powf(10000.f, -(float)(2 * j) / 32.f);
        rope[2 * i] = cosf(ang); rope[2 * i + 1] = sinf(ang);
    }
}
struct CvItem { const float* src; bf16_t* dst; };
__device__ __forceinline__ CvItem cv_decode(ArgsRef a, int it) {
    CvItem d;
    if (it >= 3072 * 8) { const int r = it - 3072 * 8; const int kb = r / 32, nb = r % 32; d.src = a.w_out + (size_t)(64 * kb) * 1024 + 32 * nb; d.dst = (bf16_t*)(a.ws + WS_WOUT_T) + (size_t)(32 * nb) * 1024 + 64 * kb; return d; }
    const int nb = it & 31, kb = (it >> 5) & 15, e = (it >> 9) & 15, mat = it >> 13;
    const int n0 = 32 * nb, k0 = 64 * kb;
    if (mat < 2) { d.src = (mat == 0 ? a.w_gate : a.w_up) + (size_t)e * 1024 * 1024 + (size_t)k0 * 1024 + n0; d.dst = (bf16_t*)(a.ws + WS_WGU) + (size_t)e * 2048 * 1024 + (size_t)(256 * (n0 >> 7) + mat * 128 + (n0 & 127)) * 1024 + k0; }
    else { d.src = a.w_down + (size_t)e * 1024 * 1024 + (size_t)k0 * 1024 + n0; d.dst = (bf16_t*)(a.ws + WS_WD) + (size_t)e * 1024 * 1024 + (size_t)n0 * 1024 + k0; }
    return d;
}
struct CvRegs { f32x4 v[8]; };
__device__ __forceinline__ void cv_load(CvRegs& r, const CvItem& d, int lane) {
    const int kq = lane >> 3, n4 = (lane & 7) * 4;
#pragma unroll
    for (int i = 0; i < 8; ++i) r.v[i] = *(const f32x4*)(d.src + (size_t)(kq + 8 * i) * 1024 + n4);
}
__device__ __forceinline__ void cv_finish(const CvRegs& r, const CvItem& d, LAS float* scr, int lane) {
    {   const int kq = lane >> 3, n4 = (lane & 7) * 4;
#pragma unroll
        for (int i = 0; i < 8; ++i) { LAS float* sp = scr + (kq + 8 * i) * 33 + n4; sp[0] = r.v[i][0]; sp[1] = r.v[i][1]; sp[2] = r.v[i][2]; sp[3] = r.v[i][3]; } }
    asm volatile("s_waitcnt lgkmcnt(0)" ::: "memory");
    const int c = lane & 7;
#pragma unroll
    for (int j = 0; j < 4; ++j) { const int n = (lane >> 3) + 8 * j; const LAS float* s = scr + (8 * c) * 33 + n;
        uint4 o; o.x = pk2(s[0 * 33], s[1 * 33]); o.y = pk2(s[2 * 33], s[3 * 33]); o.z = pk2(s[4 * 33], s[5 * 33]); o.w = pk2(s[6 * 33], s[7 * 33]);
        *(uint4*)(d.dst + (size_t)n * 1024 + 8 * c) = o; }
    asm volatile("s_waitcnt lgkmcnt(0)" ::: "memory");
}
__device__ __forceinline__ void cv_stream(ArgsRef a, LAS float* scr, int lane, int it0, int step, int n) {
    if (n <= 0) return;
    CvItem d = cv_decode(a, it0); CvRegs cur; cv_load(cur, d, lane);
    for (int j = 0; j < n; ++j) {
        CvItem dn = d; CvRegs nx = cur;
        if (j + 1 < n) { dn = cv_decode(a, it0 + (j + 1) * step); cv_load(nx, dn, lane); }
        cv_finish(cur, d, scr, lane);
        d = dn; cur = nx;
    }
}
namespace att {
using bf16x8 = __attribute__((ext_vector_type(8))) short;
using s16x4 = __attribute__((ext_vector_type(4))) short;
using f32x16 = __attribute__((ext_vector_type(16))) float;
typedef short v4i16_t __attribute__((ext_vector_type(4)));
constexpr int KV = 64, NTILE = LT / KV, SLOTB = 32768, NSLOT = 3;
constexpr int OFF_WSF = 4 * SLOTB;
constexpr int OFF_UW = 160 * 1024 - 256 + 128;
__device__ __forceinline__ int crow(int r, int hi) { return (r & 3) + 8 * (r >> 2) + 4 * hi; }
__device__ __forceinline__ void glds16(const void* gsrc, unsigned lds_dst) { unsigned keep;
    asm volatile("s_mov_b32 %0, m0\n\ts_mov_b32 m0, %2\n\ts_nop 0\n\tglobal_load_lds_dwordx4 %1, off\n\ts_mov_b32 m0, %0" : "=&s"(keep) : "v"(gsrc), "s"(lds_dst) : "memory"); }
__device__ __forceinline__ void glds16s(const void* sbase, unsigned voff, unsigned lds_dst) { unsigned keep;
    asm volatile("s_mov_b32 %0, m0\n\ts_mov_b32 m0, %3\n\ts_nop 0\n\tglobal_load_lds_dwordx4 %2, %1\n\ts_mov_b32 m0, %0" : "=&s"(keep) : "s"(sbase), "v"(voff), "s"(lds_dst) : "memory"); }
__device__ __forceinline__ s16x4 vtr(const LAS unsigned char* p) { return __builtin_bit_cast(s16x4, __builtin_amdgcn_ds_read_tr16_b64_v4i16((LAS v4i16_t*)p)); }
__device__ __forceinline__ unsigned cvtpk(float lo, float hi) { return cvt2bf(lo, hi); }
#define ATT_BAR_V(N) asm volatile("s_waitcnt vmcnt(" #N ") lgkmcnt(0)\n\ts_barrier" ::: "memory")
#define ATT_BAR() asm volatile("s_waitcnt lgkmcnt(0)\n\ts_barrier" ::: "memory")

constexpr int KSPLIT = 2, NTS = NTILE / KSPLIT;
#define SBAR() __builtin_amdgcn_sched_barrier(0)
__device__ __forceinline__ void attn_unit(ArgsRef a, unsigned char* shm, int b, int h, int qb, int ks) {
    const int tid = tid_fresh(), lane = tid & 63, r32 = lane & 31, hi = lane >> 5;
    const int wid = __builtin_amdgcn_readfirstlane(tid >> 6);
    const int map = wid >> 2, qs = wid & 3;
    const bf16_t* Q = (const bf16_t*)(a.ws + WS_QG); const bf16_t* Kb = (const bf16_t*)(a.ws + WS_K); const bf16_t* Vb = (const bf16_t*)(a.ws + WS_V);
    const size_t m0 = (size_t)b * L + qb * 128 + qs * 32;
    const bf16_t* Kh = Kb + ((size_t)b * LT + (size_t)ks * NTS * KV) * 512 + h * 128;
    const bf16_t* Vh = Vb + ((size_t)b * LT + (size_t)ks * NTS * KV) * 512 + h * 128;
    const unsigned lds0 = (unsigned)(uintptr_t)shm;
    const LAS unsigned char* shm3 = (const LAS unsigned char*)shm;
    LAS float* wsf = (LAS float*)(shm3 + OFF_WSF) + wid * 64;
    bf16x8 qr[4];
#pragma unroll
    for (int d0 = 0; d0 < 4; ++d0) qr[d0] = *(const bf16x8*)(Q + (m0 + r32) * 1024 + h * 128 + map * 64 + 16 * d0 + 8 * hi);
    const int drow0 = 8 * wid + (lane >> 4), drow1 = drow0 + 4, dc = lane & 15;
    const unsigned ko0 = (unsigned)(drow0 * 1024 + (dc ^ (drow0 & 15)) * 16), ko1 = (unsigned)(drow1 * 1024 + (dc ^ (drow1 & 15)) * 16);
    const unsigned vo0 = (unsigned)(drow0 * 1024 + ((((dc >> 2) ^ (drow0 & 3)) << 2) | (dc & 3)) * 16), vo1 = (unsigned)(drow1 * 1024 + ((((dc >> 2) ^ (drow1 & 3)) << 2) | (dc & 3)) * 16);
    const unsigned kdst = lds0 + (2 * wid) * 1024, vdst = lds0 + 16384 + (2 * wid) * 1024;
#define A2_DMA1(piece, t, slot) do { const unsigned char* kt_ = (const unsigned char*)Kh + (size_t)(t) * KV * 1024; const unsigned char* vt_ = (const unsigned char*)Vh + (size_t)(t) * KV * 1024; const unsigned so_ = (unsigned)(slot) * SLOTB; \
        if ((piece) == 0) glds16s(kt_, ko0, (unsigned)__builtin_amdgcn_readfirstlane(kdst + so_)); else if ((piece) == 1) glds16s(kt_, ko1, (unsigned)__builtin_amdgcn_readfirstlane(kdst + so_ + 1024)); \
        else if ((piece) == 2) glds16s(vt_, vo0, (unsigned)__builtin_amdgcn_readfirstlane(vdst + so_)); else glds16s(vt_, vo1, (unsigned)__builtin_amdgcn_readfirstlane(vdst + so_ + 1024)); } while (0)
#define A2_DMA(t, slot) do { A2_DMA1(0, t, slot); A2_DMA1(1, t, slot); A2_DMA1(2, t, slot); A2_DMA1(3, t, slot); } while (0)
    A2_DMA(0, 0); A2_DMA(1, 1);
    __builtin_amdgcn_s_waitcnt(0);
    const int q4 = (lane & 15) >> 2;
    int kof[4], vof[4];
#pragma unroll
    for (int d0 = 0; d0 < 4; ++d0) { kof[d0] = r32 * 256 + (((8 * map + 2 * d0 + hi) ^ (r32 & 15)) << 4);
                                     vof[d0] = 16384 + (4 * hi + q4) * 256 + ((lane >> 4) & 1) * 32 + (lane & 3) * 8 + ((d0 ^ q4) << 6); }
    f32x16 o[4];
#pragma unroll
    for (int d0 = 0; d0 < 4; ++d0)
#pragma unroll
        for (int r = 0; r < 16; ++r) o[d0][r] = 0.f;
    float mref = 0.f, lsum = 0.f;
    f32x16 negm;
#pragma unroll
    for (int r = 0; r < 16; ++r) negm[r] = 0.f;
    f32x16 pA0, pA1, pB0, pB1;
    bf16x8 pw[4];
#define A2_ROWMAX(C0, C1, rm) do { float rm2_; rm = __builtin_fmaxf(__builtin_fmaxf(C0[0], C1[0]), C0[1]); rm2_ = __builtin_fmaxf(__builtin_fmaxf(C1[1], C0[2]), C1[2]); \
        _Pragma("unroll") for (int r = 3; r < 15; r += 2) { rm = __builtin_fmaxf(__builtin_fmaxf(rm, C0[r]), C1[r]); rm2_ = __builtin_fmaxf(__builtin_fmaxf(rm2_, C0[r + 1]), C1[r + 1]); } \
        rm = __builtin_fmaxf(__builtin_fmaxf(rm, C0[15]), C1[15]); rm = __builtin_fmaxf(rm, rm2_); \
        { auto sw_ = __builtin_amdgcn_permlane32_swap(__float_as_uint(rm), __float_as_uint(rm), false, false); rm = __builtin_fmaxf(__uint_as_float(sw_[0]), __uint_as_float(sw_[1])); } } while (0)
#define A2_RESCALE_O(alpha) do { if (hi == 0) wsf[r32] = (alpha); \
        _Pragma("unroll") for (int r = 0; r < 16; ++r) { const float f = wsf[crow(r, hi)]; _Pragma("unroll") for (int d0 = 0; d0 < 4; ++d0) o[d0][r] *= f; } } while (0)
#define A2_VF(g) (bf16x8){vlo[(g) % 3][0], vlo[(g) % 3][1], vlo[(g) % 3][2], vlo[(g) % 3][3], vhi[(g) % 3][0], vhi[(g) % 3][1], vhi[(g) % 3][2], vhi[(g) % 3][3]}
#define A2_VRD(g) do { vlo[(g) % 3] = vtr(vb + vof[(g) >> 2] + ((g) & 3) * 4096); vhi[(g) % 3] = vtr(vb + vof[(g) >> 2] + ((g) & 3) * 4096 + 2048); } while (0)
    ATT_BAR_V(0);
    A2_DMA(2, 2);
    {
        const LAS unsigned char* kb = shm3;
        pA0 = negm; pA1 = negm;
#pragma unroll
        for (int d0 = 0; d0 < 4; ++d0) { const bf16x8 k0 = *(const LAS bf16x8*)(kb + kof[d0]), k1 = *(const LAS bf16x8*)(kb + kof[d0] + 8192);
            pA0 = __builtin_amdgcn_mfma_f32_32x32x16_bf16(k0, qr[d0], pA0, 0, 0, 0); pA1 = __builtin_amdgcn_mfma_f32_32x32x16_bf16(k1, qr[d0], pA1, 0, 0, 0); }
        float rm; A2_ROWMAX(pA0, pA1, rm);
        if (__any(rm > 8.f)) { const float dl = fmaxf(rm, 0.f); mref += dl;
#pragma unroll
            for (int r = 0; r < 16; ++r) { pA0[r] -= dl; pA1[r] -= dl; negm[r] = -mref; } }
#pragma unroll
        for (int r = 0; r < 16; ++r) { pA0[r] = __builtin_amdgcn_exp2f(pA0[r]); pA1[r] = __builtin_amdgcn_exp2f(pA1[r]); }
    }
#define A2_STEP(C0, C1, P0, P1, t_, DO_DMA) do { \
        const LAS unsigned char* kb = shm3 + ((t_) & 3) * SLOTB; const LAS unsigned char* vb = shm3 + (((t_) - 1) & 3) * SLOTB; \
        bf16x8 kf[3];     \
        kf[0] = *(const LAS bf16x8*)(kb + kof[0]); kf[1] = *(const LAS bf16x8*)(kb + kof[0] + 8192); \
        s16x4 vlo[3], vhi[3]; \
        C0 = negm; C1 = negm; float sacc = 0.f; u32x4 w_[4]; SBAR(); \
        _Pragma("unroll") for (int i = 0; i < 8; ++i) { \
            if (i + 2 < 8) kf[(i + 2) % 3] = *(const LAS bf16x8*)(kb + kof[(i + 2) >> 1] + ((i + 2) & 1) * 8192); \
            if (i == 6) A2_VRD(0); if (i == 7) A2_VRD(1); \
            if (i & 1) C1 = __builtin_amdgcn_mfma_f32_32x32x16_bf16(kf[i % 3], qr[i >> 1], C1, 0, 0, 0); else C0 = __builtin_amdgcn_mfma_f32_32x32x16_bf16(kf[i % 3], qr[i >> 1], C0, 0, 0, 0); \
            const int e_ = 4 * (i & 3); \
            if (i < 4) { sacc += P0[e_]; sacc += P0[e_ + 1]; sacc += P0[e_ + 2]; sacc += P0[e_ + 3]; asm volatile("" : "+v"(sacc)); w_[i >> 1][(i & 1) * 2] = cvtpk(P0[e_], P0[e_ + 1]); w_[i >> 1][(i & 1) * 2 + 1] = cvtpk(P0[e_ + 2], P0[e_ + 3]); } \
            else       { sacc += P1[e_]; sacc += P1[e_ + 1]; sacc += P1[e_ + 2]; sacc += P1[e_ + 3]; asm volatile("" : "+v"(sacc)); w_[i >> 1][(i & 1) * 2] = cvtpk(P1[e_], P1[e_ + 1]); w_[i >> 1][(i & 1) * 2 + 1] = cvtpk(P1[e_ + 2], P1[e_ + 3]); } \
            asm volatile("" : "+v"(w_[i >> 1]));     \
            SBAR(); } \
        lsum += sacc; \
        _Pragma("unroll") for (int k_ = 0; k_ < 4; ++k_) pw[k_] = __builtin_bit_cast(bf16x8, w_[k_]); \
        float rm; A2_ROWMAX(C0, C1, rm); \
        const bool resc = __any(rm > 8.f); float alpha = 1.f; \
        if (resc) { const float dl = fmaxf(rm, 0.f); mref += dl; alpha = __builtin_amdgcn_exp2f(-dl); \
            _Pragma("unroll") for (int r = 0; r < 16; ++r) { C0[r] -= dl; C1[r] -= dl; negm[r] = -mref; } } \
        SBAR(); \
        _Pragma("unroll") for (int g = 0; g < 16; ++g) { \
            if (g + 2 < 16) A2_VRD(g + 2); \
            o[g >> 2] = __builtin_amdgcn_mfma_f32_32x32x16_bf16(pw[g & 3], A2_VF(g), o[g >> 2], 0, 0, 0); \
            if (g < 8) { C0[2 * g] = __builtin_amdgcn_exp2f(C0[2 * g]); C0[2 * g + 1] = __builtin_amdgcn_exp2f(C0[2 * g + 1]); asm volatile("" : "+v"(C0)); } \
            else { C1[2 * (g - 8)] = __builtin_amdgcn_exp2f(C1[2 * (g - 8)]); C1[2 * (g - 8) + 1] = __builtin_amdgcn_exp2f(C1[2 * (g - 8) + 1]); asm volatile("" : "+v"(C1)); } \
            if (DO_DMA && (g & 3) == 3) A2_DMA1(g >> 2, (t_) + 2, ((t_) + 2) & 3); \
            SBAR(); } \
        if (resc) { lsum *= alpha; A2_RESCALE_O(alpha); } } while (0)
    int t = 1;
    for (; t + 3 < NTS; t += 2) {
        ATT_BAR_V(4); A2_STEP(pB0, pB1, pA0, pA1, t, true);
        ATT_BAR_V(4); A2_STEP(pA0, pA1, pB0, pB1, t + 1, true);
    }
    ATT_BAR_V(4); A2_STEP(pB0, pB1, pA0, pA1, t, true); ++t;
    ATT_BAR_V(4); A2_STEP(pA0, pA1, pB0, pB1, t, false); ++t;
    ATT_BAR_V(0); A2_STEP(pB0, pB1, pA0, pA1, t, false);
    {
        float sacc = 0.f;
#pragma unroll
        for (int r = 0; r < 16; ++r) sacc += pB0[r] + pB1[r];
        lsum += sacc;
#pragma unroll
        for (int s = 0; s < 2; ++s) { u32x4 w0, w1;
            w0.x = cvtpk(pB0[8 * s], pB0[8 * s + 1]); w0.y = cvtpk(pB0[8 * s + 2], pB0[8 * s + 3]); w0.z = cvtpk(pB0[8 * s + 4], pB0[8 * s + 5]); w0.w = cvtpk(pB0[8 * s + 6], pB0[8 * s + 7]);
            w1.x = cvtpk(pB1[8 * s], pB1[8 * s + 1]); w1.y = cvtpk(pB1[8 * s + 2], pB1[8 * s + 3]); w1.z = cvtpk(pB1[8 * s + 4], pB1[8 * s + 5]); w1.w = cvtpk(pB1[8 * s + 6], pB1[8 * s + 7]);
            pw[s] = __builtin_bit_cast(bf16x8, w0); pw[2 + s] = __builtin_bit_cast(bf16x8, w1); }
        const LAS unsigned char* vb = shm3 + ((NTS - 1) & 3) * SLOTB;
#pragma unroll
        for (int d0 = 0; d0 < 4; ++d0)
#pragma unroll
            for (int k2 = 0; k2 < 4; ++k2) { const s16x4 lo = vtr(vb + vof[d0] + k2 * 4096), hv = vtr(vb + vof[d0] + k2 * 4096 + 2048);
                const bf16x8 vf = {lo[0], lo[1], lo[2], lo[3], hv[0], hv[1], hv[2], hv[3]};
                o[d0] = __builtin_amdgcn_mfma_f32_32x32x16_bf16(pw[k2], vf, o[d0], 0, 0, 0); }
    }
#undef A2_STEP
#undef A2_VRD
#undef A2_VF
#undef A2_ROWMAX
#undef A2_DMA
#undef A2_DMA1
    const float lt = lsum + __shfl_xor(lsum, 32);
    const float inv = 1.f / lt;
    ATT_BAR();
    if (hi == 0) wsf[r32] = inv;
#pragma unroll
    for (int r = 0; r < 16; ++r) { const float f = wsf[crow(r, hi)];
#pragma unroll
        for (int d0 = 0; d0 < 4; ++d0) o[d0][r] *= f; }
    const int piece = ks * 2 + map;
    bf16_t* PO = (bf16_t*)(a.ws + (piece == 0 ? WS_PO0 : piece == 1 ? WS_PO1 : piece == 2 ? WS_PO2 : WS_PO3));
    LAS bf16_t* stg = (LAS bf16_t*)shm3 + wid * 4096;
#pragma unroll
    for (int d0 = 0; d0 < 4; ++d0)
#pragma unroll
        for (int r = 0; r < 16; ++r) stg[crow(r, hi) * 128 + 32 * d0 + r32] = f2bf(o[d0][r]);
    asm volatile("s_waitcnt lgkmcnt(0)" ::: "memory");
#pragma unroll
    for (int i = 0; i < 8; ++i) { const int row = i * 4 + (lane >> 4), ch = lane & 15;
        const u32x4 v = *(const LAS u32x4*)(stg + row * 128 + ch * 8);
        *(u32x4*)(PO + (m0 + row) * 512 + h * 128 + ch * 8) = v; }
    if (hi == 0) { float2 ml; ml.x = mref; ml.y = lt; *(float2*)((float*)(a.ws + WS_ML) + (((size_t)piece * M + m0 + r32) * 4 + h) * 2) = ml; }
    ATT_BAR();
}
#undef SBAR
}
__device__ __forceinline__ void ph_attn(ArgsRef a, unsigned char* shm, int pass = 0) {
    const int tix_ = tid_fresh();
    unsigned* cnt = (unsigned*)(a.ws + WS_CTL) + 8192 + pass * 1024;
    volatile LAS int* uw = (volatile LAS int*)((LAS unsigned char*)shm + att::OFF_UW);
    for (;;) {
        if (tix_ == 0) {
            int u = -1; const int q = blockIdx.x & 7;
            for (int s = 0; s < 8; ++s) { const int k = (q + s) & 7; const unsigned v = __hip_atomic_fetch_add(cnt + k * 64, 1u, __ATOMIC_RELAXED, __HIP_MEMORY_SCOPE_AGENT); if (v < 128u) { u = k * 128 + (int)v; break; } }
            uw[0] = u;
        }
        __syncthreads();
        const int u = uw[0];
        __syncthreads();
        if (u < 0) break;
        att::attn_unit(a, shm, u >> 9, (u >> 7) & 3, u & 63, (u >> 6) & 1);
    }
    if (pass) return;
    unsigned* ctl = (unsigned*)(a.ws + WS_CTL);
    if (tix_ == 0) { unsigned sp = 0; while (__hip_atomic_load(ctl + 12288, __ATOMIC_RELAXED, __HIP_MEMORY_SCOPE_AGENT) < 16u && ++sp < (1u << 22)) __builtin_amdgcn_s_sleep(8); }
    __syncthreads();
    {
        const int lane = tix_ & 63, wave = tix_ >> 6;
        LAS float* scr = (LAS float*)((LAS unsigned char*)shm + wave * 16384);
        int nb = 0;
        if (tix_ == 0) nb = (int)__hip_atomic_fetch_add(ctl + 12288 + 64, 1u, __ATOMIC_RELAXED, __HIP_MEMORY_SCOPE_AGENT);
        for (;;) {
            if (tix_ == 0) uw[0] = nb;
            __syncthreads();
            const int bq = uw[0];
            __syncthreads();
            if (bq >= 528) break;
            if (tix_ == 0) nb = (int)__hip_atomic_fetch_add(ctl + 12288 + 64, 1u, __ATOMIC_RELAXED, __HIP_MEMORY_SCOPE_AGENT);
            const int it0 = bq * 32 + wave;
            cv_stream(a, scr, lane, it0 < 2048 * 8 ? it0 : it0 + 1024 * 8, 8, 4);
        }
    }
}
__device__ __forceinline__ void ph_fill_wdown(ArgsRef a, unsigned char* shm) {
    const int tix_ = tid_fresh();
    if ((int)blockIdx.x < 32 && (int)gridDim.x > 32) return;
    __syncthreads();
    const int lane = tix_ & 63, wave = tix_ >> 6;
    LAS float* scr = (LAS float*)((LAS unsigned char*)shm + wave * 16384);
    const int first = (int)gridDim.x > 32 ? 32 : 0;
    const int g = ((int)blockIdx.x - first) * 8 + wave, ng = ((int)gridDim.x - first) * 8;
    const int n = g < 8192 ? (8192 - 1 - g) / ng + 1 : 0;
    cv_stream(a, scr, lane, 2048 * 8 + g, ng, n);
}

__device__ __forceinline__ int gdn_row(int d, int b, int cs, int i) {
    const bool isctx = cs < 4; const int n = isctx ? cs : cs - 4; const int len = isctx ? LC : L; const int base = b * LT + (isctx ? 0 : LC);
    const int p = n * 64 + i; return base + (d == 0 ? p : len - 1 - p);
}
namespace gdn {
using bf16x8 = __attribute__((ext_vector_type(8))) short;
using f32x16 = __attribute__((ext_vector_type(16))) float;
__device__ __forceinline__ int crow(int r, int hi) { return (r & 3) + 8 * (r >> 2) + 4 * hi; }
__device__ __forceinline__ int pch(int x) { return 2 * (x >> 4) + ((x >> 2) & 1); }
__device__ __forceinline__ int pj(int x) { return 4 * ((x >> 3) & 1) + (x & 3); }
__device__ __forceinline__ unsigned cvtpk(float lo, float hi) { return cvt2bf(lo, hi); }
__device__ __forceinline__ bf16x8 pack8(const f32x16& x, int s) {
    u32x4 w; w.x = cvtpk(x[8 * s], x[8 * s + 1]); w.y = cvtpk(x[8 * s + 2], x[8 * s + 3]); w.z = cvtpk(x[8 * s + 4], x[8 * s + 5]); w.w = cvtpk(x[8 * s + 6], x[8 * s + 7]);
    return __builtin_bit_cast(bf16x8, w);
}
#define GDN_MFMA(A, B, C) __builtin_amdgcn_mfma_f32_32x32x16_bf16((A), (B), (C), 0, 0, 0)
typedef short v4i16g __attribute__((ext_vector_type(4)));
using s16x4 = __attribute__((ext_vector_type(4))) short;
__device__ __forceinline__ s16x4 vtr(const LAS unsigned char* p) { return __builtin_bit_cast(s16x4, __builtin_amdgcn_ds_read_tr16_b64_v4i16((LAS v4i16g*)p)); }
__device__ __forceinline__ bf16x8 trfrag(const LAS unsigned char* img, int r0, int r1, int tile, int lane) {
    const int q = (lane & 15) >> 2, po = ((lane >> 4) & 1) * 32 + (lane & 3) * 8;
    const s16x4 lo = vtr(img + (r0 + q) * 256 + ((tile ^ q) << 6) + po), hv = vtr(img + (r1 + q) * 256 + ((tile ^ q) << 6) + po);
    return (bf16x8){lo[0], lo[1], lo[2], lo[3], hv[0], hv[1], hv[2], hv[3]};
}
constexpr int AQK_GL_OFF = 4096;
constexpr int P_KNA = 0, P_QNA = 16384, P_KBT = 32768, P_VBT = 49152, P_QDS = 65536, P_KDTS = 81920, P_AF = 98304, P_TF = 115200, P_TIMG = 132096, P_GS = 140288, P_MT = 141312, P_MT2 = 143488;
__device__ __forceinline__ void prep(ArgsRef a, unsigned char* shm) {
    LAS unsigned char* s3 = (LAS unsigned char*)shm;
    LAS bf16_t* KnA = (LAS bf16_t*)(s3 + P_KNA); LAS bf16_t* QnA = (LAS bf16_t*)(s3 + P_QNA); LAS bf16_t* KBt = (LAS bf16_t*)(s3 + P_KBT); LAS bf16_t* VBt = (LAS bf16_t*)(s3 + P_VBT);
    LAS bf16_t* QDs = (LAS bf16_t*)(s3 + P_QDS); LAS bf16_t* KDTs = (LAS bf16_t*)(s3 + P_KDTS);
    LAS float* Af = (LAS float*)(s3 + P_AF); LAS float* Tf = (LAS float*)(s3 + P_TF); LAS bf16_t* TImg = (LAS bf16_t*)(s3 + P_TIMG);
    LAS float* gc = (LAS float*)(s3 + P_GS); LAS float* be = gc + 64; LAS float* eg = gc + 128; LAS float* ekd = gc + 192;
    LAS float* Mt = (LAS float*)(s3 + P_MT); LAS float* Mt2 = (LAS float*)(s3 + P_MT2);
    const bf16_t* GQKVr = (const bf16_t*)(a.ws + WS_GQKV);
    unsigned char* WN = a.ws + WS_WN; unsigned char* QD = a.ws + WS_QD; unsigned char* AQK = a.ws + WS_AQK; unsigned char* UB = a.ws + WS_UB; unsigned char* KDT = a.ws + WS_KDT; float* GL = (float*)(a.ws + WS_GL);
    const int t0 = tid_fresh();
    const int w = __builtin_amdgcn_readfirstlane(t0 >> 6);
    u32x4 nxm[6], nx0[6], nxp[6]; float ngx = 0.f, ngb = 0.f;
#define PREP_FETCH(ci_) do { const int cs_ = (ci_) % NCH, h_ = ((ci_) / NCH) & 3, b_ = ((ci_) / (NCH * 4)) % NB, d_ = (ci_) / (NCH * 4 * NB); \
        _Pragma("unroll") for (int kk = 0; kk < 6; ++kk) { const int p = t0 + NT * kk, mat = kk >> 1, row = (p >> 4) & 63, ch = p & 15; \
            const int r = gdn_row(d_, b_, cs_, row), j = r % LT; \
            const bool has_prev = !(j == 0 || j == LC), has_next = !(j == LC - 1 || j == LT - 1); \
            const bf16_t* gp = GQKVr + (size_t)r * 1536 + mat * 512 + h_ * 128 + ch * 8; \
            const u32x4 z = {0u, 0u, 0u, 0u}; \
            nx0[kk] = *(const u32x4*)gp; nxm[kk] = has_prev ? *(const u32x4*)(gp - 1536) : z; nxp[kk] = has_next ? *(const u32x4*)(gp + 1536) : z; } \
        if (t0 < 64) { const float* abr = (const float*)(a.ws + WS_AB) + (size_t)gdn_row(d_, b_, cs_, t0) * 16 + d_ * 4 + h_; ngx = abr[0]; ngb = abr[8]; } } while (0)
    if ((int)blockIdx.x < NCI) PREP_FETCH((int)blockIdx.x);
    for (int ci = blockIdx.x; ci < NCI; ci += gridDim.x) {
        const int cs = ci % NCH, h = (ci / NCH) & 3, b = (ci / (NCH * 4)) % NB, d = ci / (NCH * 4 * NB);
        const bool lat = cs >= 4;
        int t = t0; asm volatile("" : "+v"(t));
        const int lane = t & 63, r32 = lane & 31, hi = lane >> 5;
        u32x4 rawm[6], raw0[6], rawp[6];
#pragma unroll
        for (int kk = 0; kk < 6; ++kk) { rawm[kk] = nxm[kk]; raw0[kk] = nx0[kk]; rawp[kk] = nxp[kk]; }
        const float gxa = ngx, gxb = ngb;
        __syncthreads();
        if (ci + (int)gridDim.x < NCI) PREP_FETCH(ci + (int)gridDim.x);
        if (t < 64) {
            const float xa = gxa + a.dt_bias[d * 4 + h];
            float g = -expf(a.a_log[d * 4 + h]) * (fmaxf(xa, 0.f) + log1pf(expf(-fabsf(xa))));
            const float bt = 1.f / (1.f + expf(-gxb));
#pragma unroll
            for (int o = 1; o < 64; o <<= 1) { const float v = __shfl_up(g, o); if (lane >= o) g += v; }
            const float gl = __shfl(g, 63);
            gc[t] = g; be[t] = bt; eg[t] = __expf(g); ekd[t] = __expf(gl - g);
            if (t == 63) *(float*)(AQK + (size_t)ci * 8192 + AQK_GL_OFF) = __expf(g);
        }
        for (int i = t; i < 64 * 65; i += NT) Tf[i] = 0.f;
        __syncthreads();
        float cw[3][8];
#pragma unroll
        for (int kk = 0; kk < 6; ++kk) {
            const int p = t + NT * kk, mat = kk >> 1, row = (p >> 4) & 63, ch = p & 15;
            float v[8]; float ss = 0.f;
            if ((kk & 1) == 0) {
                const float* cwp = a.conv_w + mat * 512 + h * 128 + ch * 8;
#pragma unroll
                for (int tp = 0; tp < 3; ++tp) { const f32x4 c0v = *(const f32x4*)(cwp + tp * 1536), c1v = *(const f32x4*)(cwp + tp * 1536 + 4);
                    cw[tp][0] = c0v[0]; cw[tp][1] = c0v[1]; cw[tp][2] = c0v[2]; cw[tp][3] = c0v[3]; cw[tp][4] = c1v[0]; cw[tp][5] = c1v[1]; cw[tp][6] = c1v[2]; cw[tp][7] = c1v[3]; }
            }
#pragma unroll
            for (int e = 0; e < 8; ++e) {
                const unsigned wm = rawm[kk][e >> 1], w0 = raw0[kk][e >> 1], wp = rawp[kk][e >> 1];
                const float fm = (e & 1) ? __uint_as_float(wm & 0xffff0000u) : __uint_as_float(wm << 16);
                const float f0 = (e & 1) ? __uint_as_float(w0 & 0xffff0000u) : __uint_as_float(w0 << 16);
                const float fp = (e & 1) ? __uint_as_float(wp & 0xffff0000u) : __uint_as_float(wp << 16);
                v[e] = siluf(cw[0][e] * fm + cw[1][e] * f0 + cw[2][e] * fp); ss += v[e] * v[e]; }
            if (mat < 2) {
                ss += __shfl_xor(ss, 1); ss += __shfl_xor(ss, 2); ss += __shfl_xor(ss, 4); ss += __shfl_xor(ss, 8);
                const float sc = rsqrtf(ss + EPS) * (mat == 0 ? 0.08838834764831845f : 1.f);
#pragma unroll
                for (int e = 0; e < 8; ++e) v[e] *= sc;
            }
            u32x4 raw; raw.x = pk2(v[0], v[1]); raw.y = pk2(v[2], v[3]); raw.z = pk2(v[4], v[5]); raw.w = pk2(v[6], v[7]);
#pragma unroll
            for (int e = 0; e < 8; ++e) v[e] = (e & 1) ? __uint_as_float(raw[e >> 1] & 0xffff0000u) : __uint_as_float(raw[e >> 1] << 16);
            if (mat == 1) {
                *(LAS u32x4*)(KnA + (ch * 64 + row) * 8) = raw;
                const float s1 = be[row] * eg[row], s2 = ekd[row];
                const int pos = row * 128 + (((((ch >> 2) ^ (row & 3)) << 2) | (ch & 3)) * 8);
                u32x4 w1, w2; w1.x = pk2(v[0] * s1, v[1] * s1); w1.y = pk2(v[2] * s1, v[3] * s1); w1.z = pk2(v[4] * s1, v[5] * s1); w1.w = pk2(v[6] * s1, v[7] * s1);
                w2.x = pk2(v[0] * s2, v[1] * s2); w2.y = pk2(v[2] * s2, v[3] * s2); w2.z = pk2(v[4] * s2, v[5] * s2); w2.w = pk2(v[6] * s2, v[7] * s2);
                *(LAS u32x4*)(KBt + pos) = w1; *(LAS u32x4*)(KDTs + pos) = w2;
            } else if (mat == 0) {
                *(LAS u32x4*)(QnA + (ch * 64 + row) * 8) = raw;
                if (lat) {
                    const float s = eg[row];
                    u32x2 q0, q1; q0.x = pk2(v[0] * s, v[1] * s); q0.y = pk2(v[2] * s, v[3] * s); q1.x = pk2(v[4] * s, v[5] * s); q1.y = pk2(v[6] * s, v[7] * s);
                    const int cb = 2 * (ch >> 1), jo = 4 * (ch & 1);
                    *(LAS u32x2*)(QDs + ((cb + 0) * 64 + row) * 8 + jo) = q0;
                    *(LAS u32x2*)(QDs + ((cb + 1) * 64 + row) * 8 + jo) = q1;
                }
            } else {
                const float s = be[row];
                const int pos = row * 128 + (((((ch >> 2) ^ (row & 3)) << 2) | (ch & 3)) * 8);
                u32x4 w1; w1.x = pk2(v[0] * s, v[1] * s); w1.y = pk2(v[2] * s, v[3] * s); w1.z = pk2(v[4] * s, v[5] * s); w1.w = pk2(v[6] * s, v[7] * s);
                *(LAS u32x4*)(VBt + pos) = w1;
            }
        }
        __syncthreads();
        if (w < 3 || (w < 6 && lat)) {
            const int job = w < 3 ? w : w - 3; const int it = job == 0 ? 0 : 1, jt = job == 2 ? 1 : 0;
            f32x16 acc;
#pragma unroll
            for (int r = 0; r < 16; ++r) acc[r] = 0.f;
            if (w < 3) {
#pragma unroll
                for (int ks = 0; ks < 8; ++ks) {
                    const bf16x8 fa = *(const LAS bf16x8*)(KnA + ((2 * ks + hi) * 64 + 32 * it + r32) * 8), fb = *(const LAS bf16x8*)(KnA + ((2 * ks + hi) * 64 + 32 * jt + r32) * 8);
                    acc = GDN_MFMA(fa, fb, acc);
                }
                const int j = 32 * jt + r32; const float gj = gc[j];
#pragma unroll
                for (int r = 0; r < 16; ++r) { const int i = 32 * it + crow(r, hi); Af[i * 65 + j] = (j < i) ? be[i] * acc[r] * __expf(gc[i] - gj) : 0.f; }
            } else {
#pragma unroll
                for (int ks = 0; ks < 8; ++ks) {
                    const bf16x8 fa = *(const LAS bf16x8*)(KnA + ((2 * ks + hi) * 64 + 32 * jt + r32) * 8), fb = *(const LAS bf16x8*)(QnA + ((2 * ks + hi) * 64 + 32 * it + r32) * 8);
                    acc = GDN_MFMA(fa, fb, acc);
                }
                const int i = 32 * it + r32; const float gi = gc[i];
#pragma unroll
                for (int r = 0; r < 16; ++r) { const int j = 32 * jt + crow(r, hi); acc[r] = (j <= i) ? acc[r] * __expf(gi - gc[j]) : 0.f; }
#pragma unroll
                for (int s = 0; s < 2; ++s) { const bf16x8 pk = pack8(acc, s); *(bf16x8*)(AQK + (size_t)ci * 8192 + ((2 * (2 * jt + s) + hi) * 64 + i) * 16) = pk; }
            }
        }
        __syncthreads();
        if (t < 64) {
            const int blk = t >> 4, c = t & 15, o = 16 * blk; float x[16];
#pragma unroll
            for (int i = 0; i < 16; ++i) {
                float s = 0.f;
#pragma unroll
                for (int j = 0; j < i; ++j) s += Af[(o + i) * 65 + o + j] * x[j];
                x[i] = (i == c ? 1.f : 0.f) - s;
            }
#pragma unroll
            for (int i = 0; i < 16; ++i) Tf[(o + i) * 65 + o + c] = x[i];
        }
        __syncthreads();
        { const int pq = t >> 8, i = (t >> 4) & 15, c = t & 15, o = 32 * pq; float s = 0.f;
#pragma unroll
          for (int j = 0; j < 16; ++j) s += Af[(o + 16 + i) * 65 + o + j] * Tf[(o + j) * 65 + o + c];
          Mt[(pq * 16 + i) * 17 + c] = s; }
        __syncthreads();
        { const int pq = t >> 8, i = (t >> 4) & 15, c = t & 15, o = 32 * pq; float s = 0.f;
#pragma unroll
          for (int j = 0; j < 16; ++j) s += Tf[(o + 16 + i) * 65 + o + 16 + j] * Mt[(pq * 16 + j) * 17 + c];
          Tf[(o + 16 + i) * 65 + o + c] = -s; }
        __syncthreads();
#pragma unroll
        for (int k = 0; k < 2; ++k) { const int e = t + NT * k, i = e >> 5, c = e & 31; float s = 0.f;
#pragma unroll 8
            for (int j = 0; j < 32; ++j) s += Af[(32 + i) * 65 + j] * Tf[j * 65 + c];
            Mt2[i * 33 + c] = s; }
        __syncthreads();
#pragma unroll
        for (int k = 0; k < 2; ++k) { const int e = t + NT * k, i = e >> 5, c = e & 31; float s = 0.f;
#pragma unroll 8
            for (int j = 0; j < 32; ++j) s += Tf[(32 + i) * 65 + 32 + j] * Mt2[j * 33 + c];
            Tf[(32 + i) * 65 + c] = -s; }
        __syncthreads();
        { const int i = t >> 3, ch = t & 7; u32x4 o;
          o.x = pk2(Tf[i * 65 + 8 * ch], Tf[i * 65 + 8 * ch + 1]); o.y = pk2(Tf[i * 65 + 8 * ch + 2], Tf[i * 65 + 8 * ch + 3]);
          o.z = pk2(Tf[i * 65 + 8 * ch + 4], Tf[i * 65 + 8 * ch + 5]); o.w = pk2(Tf[i * 65 + 8 * ch + 6], Tf[i * 65 + 8 * ch + 7]);
          *(LAS u32x4*)(TImg + (ch * 64 + i) * 8) = o; }
        __syncthreads();
        {
            const int dkt = w >> 1, it = w & 1; const int nks = it == 0 ? 2 : 4;
            f32x16 acc;
#pragma unroll
            for (int r = 0; r < 16; ++r) acc[r] = 0.f;
#pragma unroll
            for (int ks = 0; ks < 4; ++ks) if (ks < nks) {
                const bf16x8 fa = trfrag((const LAS unsigned char*)KBt, 16 * ks + 8 * hi, 16 * ks + 8 * hi + 4, dkt, lane), fb = *(const LAS bf16x8*)(TImg + ((2 * ks + hi) * 64 + 32 * it + r32) * 8);
                acc = GDN_MFMA(fa, fb, acc);
            }
#pragma unroll
            for (int r = 0; r < 16; ++r) acc[r] = -acc[r];
            const int i = 32 * it + r32;
#pragma unroll
            for (int s = 0; s < 2; ++s) { const bf16x8 pk = pack8(acc, s); *(bf16x8*)(WN + (size_t)ci * 16384 + ((2 * (2 * dkt + s) + hi) * 64 + i) * 16) = pk; }
        }
        {
            const int it = w >> 2, dvt = w & 3; const int nks = it == 0 ? 2 : 4;
            f32x16 acc;
#pragma unroll
            for (int r = 0; r < 16; ++r) acc[r] = 0.f;
#pragma unroll
            for (int ks = 0; ks < 4; ++ks) if (ks < nks) {
                const bf16x8 fa = *(const LAS bf16x8*)(TImg + ((2 * ks + hi) * 64 + 32 * it + r32) * 8), fb = trfrag((const LAS unsigned char*)VBt, 16 * ks + 8 * hi, 16 * ks + 8 * hi + 4, dvt, lane);
                acc = GDN_MFMA(fa, fb, acc);
            }
            unsigned char* dst = UB + (size_t)ci * 16384 + ((it * 4 + dvt) * 64 + lane) * 32;
            *(bf16x8*)dst = pack8(acc, 0); *(bf16x8*)(dst + 16) = pack8(acc, 1);
        }
        for (int i = t; i < 1024; i += NT) {
            *(u32x4*)(KDT + (size_t)ci * 16384 + i * 16) = *(const LAS u32x4*)((const LAS unsigned char*)KDTs + i * 16);
            if (lat) *(u32x4*)(QD + (size_t)ci * 16384 + i * 16) = *(const LAS u32x4*)((const LAS unsigned char*)QDs + i * 16);
        }
    }
}
constexpr int SB_WN = 0, SB_QD = 16384, SB_KDT = 32768, SB_AQK = 49152, SBUF = 57344, SB_UB0 = 2 * SBUF;
__device__ __forceinline__ void glds16(const void* gsrc, unsigned lds_dst) { unsigned keep;
    asm volatile("s_mov_b32 %0, m0\n\ts_mov_b32 m0, %2\n\ts_nop 0\n\tglobal_load_lds_dwordx4 %1, off\n\ts_mov_b32 m0, %0" : "=&s"(keep) : "v"(gsrc), "s"(lds_dst) : "memory"); }
#define SCAN_STEP(LAT_) do { \
            const LAS unsigned char* bb = s3 + buf * SBUF; \
            const float gl = *(const LAS float*)(bb + SB_AQK + AQK_GL_OFF); \
            f32x16 U[2]; \
_Pragma("unroll") \
            for (int mt = 0; mt < 2; ++mt) { \
                const LAS u32x4* up = (const LAS u32x4*)(s3 + SB_UB0 + buf * 16384 + ((mt * 4 + sl) * 64 + lane) * 32); \
                const u32x4 u0 = up[0], u1 = up[1]; \
_Pragma("unroll") \
                for (int e = 0; e < 4; ++e) { U[mt][2 * e] = __uint_as_float(u0[e] << 16); U[mt][2 * e + 1] = __uint_as_float(u0[e] & 0xffff0000u); \
                                              U[mt][8 + 2 * e] = __uint_as_float(u1[e] << 16); U[mt][8 + 2 * e + 1] = __uint_as_float(u1[e] & 0xffff0000u); } \
            } \
            f32x16 OT[2]; \
_Pragma("unroll") \
            for (int it = 0; it < 2; ++it) \
_Pragma("unroll") \
                for (int r = 0; r < 16; ++r) OT[it][r] = 0.f; \
_Pragma("unroll") \
            for (int ks = 0; ks < 8; ++ks) { \
                const bf16x8 sb = pack8(S[ks >> 1], ks & 1); \
_Pragma("unroll") \
                for (int mt = 0; mt < 2; ++mt) { \
                    const bf16x8 fw = *(const LAS bf16x8*)(bb + SB_WN + ((2 * ks + hi) * 64 + 32 * mt + r32) * 16); \
                    U[mt] = GDN_MFMA(fw, sb, U[mt]); \
                    if (LAT_) { const bf16x8 fq = *(const LAS bf16x8*)(bb + SB_QD + ((2 * ks + hi) * 64 + 32 * mt + r32) * 16); OT[mt] = GDN_MFMA(sb, fq, OT[mt]); } \
                } \
            } \
            bf16x8 Ub[4]; \
_Pragma("unroll") \
            for (int k2 = 0; k2 < 4; ++k2) Ub[k2] = pack8(U[k2 >> 1], k2 & 1); \
            if (LAT_) { \
_Pragma("unroll") \
                for (int it = 0; it < 2; ++it) \
_Pragma("unroll") \
                    for (int k2 = 0; k2 < 4; ++k2) if (!(it == 0 && k2 >= 2)) { \
                        const bf16x8 fa = *(const LAS bf16x8*)(bb + SB_AQK + ((2 * k2 + hi) * 64 + 32 * it + r32) * 16); \
                        OT[it] = GDN_MFMA(Ub[k2], fa, OT[it]); \
                    } \
_Pragma("unroll") \
                for (int it = 0; it < 2; ++it) { \
                    const int r = gdn_row(d, b, cs, 32 * it + r32); const size_t m = (size_t)b * L + ((r % LT) - LC); \
                    float* op = OGDN + ((size_t)d * M + m) * 512 + h * 128 + 32 * sl + 4 * hi; \
_Pragma("unroll") \
                    for (int q = 0; q < 4; ++q) { const float4 v = make_float4(OT[it][4 * q], OT[it][4 * q + 1], OT[it][4 * q + 2], OT[it][4 * q + 3]); *(float4*)(op + 8 * q) = v; } \
                } \
            } \
_Pragma("unroll") \
            for (int dt = 0; dt < 4; ++dt) { \
_Pragma("unroll") \
                for (int r = 0; r < 16; ++r) S[dt][r] *= gl; \
_Pragma("unroll") \
                for (int k2 = 0; k2 < 4; ++k2) { \
                    const bf16x8 fk = trfrag(bb + SB_KDT, 16 * k2 + 4 * hi, 16 * k2 + 8 + 4 * hi, dt, lane); \
                    S[dt] = GDN_MFMA(fk, Ub[k2], S[dt]); \
                } \
            } \
        } while (0)
__device__ __forceinline__ void scan_item(ArgsRef a, unsigned char* shm, int d, int b, int h) {
    const LAS unsigned char* s3 = (const LAS unsigned char*)shm;
    const unsigned lds0 = (unsigned)(uintptr_t)shm;
    const unsigned char* WN = a.ws + WS_WN; const unsigned char* QD = a.ws + WS_QD; const unsigned char* AQK = a.ws + WS_AQK; const unsigned char* UB = a.ws + WS_UB; const unsigned char* KDT = a.ws + WS_KDT;
    float* OGDN = a.out;
    const int t = tid_fresh(), lane = t & 63, r32 = lane & 31, hi = lane >> 5;
    const int w = __builtin_amdgcn_readfirstlane(t >> 6);
    const bool comp = w < 4; const int sl = w & 3;
    const int ci0 = ((d * NB + b) * 4 + h) * NCH;
    const unsigned lo = (unsigned)(w * 1024 + lane * 16);
#define SCAN_DMA(ci_, buf_) do { const size_t c16_ = (size_t)(ci_) * 16384; const unsigned db_ = lds0 + (buf_) * SBUF + w * 1024; \
        glds16(WN + c16_ + lo, (unsigned)__builtin_amdgcn_readfirstlane(db_ + SB_WN)); glds16(WN + c16_ + 8192 + lo, (unsigned)__builtin_amdgcn_readfirstlane(db_ + SB_WN + 8192)); \
        glds16(QD + c16_ + lo, (unsigned)__builtin_amdgcn_readfirstlane(db_ + SB_QD)); glds16(QD + c16_ + 8192 + lo, (unsigned)__builtin_amdgcn_readfirstlane(db_ + SB_QD + 8192)); \
        glds16(KDT + c16_ + lo, (unsigned)__builtin_amdgcn_readfirstlane(db_ + SB_KDT)); glds16(KDT + c16_ + 8192 + lo, (unsigned)__builtin_amdgcn_readfirstlane(db_ + SB_KDT + 8192)); \
        glds16(AQK + (size_t)(ci_) * 8192 + lo, (unsigned)__builtin_amdgcn_readfirstlane(db_ + SB_AQK)); } while (0)
#define SCAN_UB(ci_, buf_) do { if (!comp) { const u32x4* g_ = (const u32x4*)(UB + (size_t)(ci_) * 16384) + (w - 4) * 256 + lane; LAS u32x4* l_ = (LAS u32x4*)((LAS unsigned char*)shm + SB_UB0 + (buf_) * 16384) + (w - 4) * 256 + lane; \
        const u32x4 x0_ = g_[0], x1_ = g_[64], x2_ = g_[128], x3_ = g_[192]; l_[0] = x0_; l_[64] = x1_; l_[128] = x2_; l_[192] = x3_; } } while (0)
    f32x16 S[4];
#pragma unroll
    for (int dt = 0; dt < 4; ++dt)
#pragma unroll
        for (int r = 0; r < 16; ++r) S[dt][r] = 0.f;
    SCAN_DMA(ci0, 0); SCAN_UB(ci0, 0);
    for (int cs = 0; cs < NCH; ++cs) {
        const int ci = ci0 + cs, buf = cs & 1; const bool lat = cs >= 4;
        asm volatile("s_waitcnt vmcnt(0) lgkmcnt(0)\n\ts_barrier" ::: "memory");
        if (cs + 1 < NCH) { SCAN_DMA(ci + 1, buf ^ 1); SCAN_UB(ci + 1, buf ^ 1); }
        if (comp) { if (lat) SCAN_STEP(true); else SCAN_STEP(false); }
    }
    asm volatile("s_waitcnt vmcnt(0) lgkmcnt(0)\n\ts_barrier" ::: "memory");
#undef SCAN_DMA
#undef SCAN_UB
#undef SCAN_STEP
}
}
__device__ __forceinline__ void ph_gdn_scan(ArgsRef a, unsigned char* shm) {
    for (int it = blockIdx.x; it < 16; it += gridDim.x) {
        gdn::scan_item(a, shm, it >> 3, (it >> 2) & 1, it & 3);
        if (threadIdx.x == 0) __hip_atomic_fetch_add((unsigned*)(a.ws + WS_CTL) + 12288, 1u, __ATOMIC_RELAXED, __HIP_MEMORY_SCOPE_AGENT);
    }
}
__device__ __forceinline__ void ph_gdn_out(ArgsRef a) {
    const int tix_ = tid_fresh();
    const float* OGDN = a.out; bf16_t* QG = (bf16_t*)(a.ws + WS_QG);
    const float* ML = (const float*)(a.ws + WS_ML);
    const float lam = ((const float*)(a.ws + WS_MOD))[3 * 6144];
    const int lane = tix_ & 63, h = lane >> 4;
    f32x4 gn0 = *(const f32x4*)(a.gdn_norm_g + (lane & 15) * 8), gn1 = *(const f32x4*)(a.gdn_norm_g + (lane & 15) * 8 + 4);
    f32x4 sg0 = *(const f32x4*)(a.subg + (lane & 15) * 8), sg1 = *(const f32x4*)(a.subg + (lane & 15) * 8 + 4);
    for (size_t m = (size_t)blockIdx.x * 8 + (tix_ >> 6); m < (size_t)M; m += (size_t)gridDim.x * 8) {
        const size_t off = m * 512 + lane * 8;
        {
            const f32x4 a0 = *(const f32x4*)(OGDN + off), a1 = *(const f32x4*)(OGDN + off + 4), b0 = *(const f32x4*)(OGDN + (size_t)M * 512 + off), b1 = *(const f32x4*)(OGDN + (size_t)M * 512 + off + 4);
            const f32x4 o0 = a0 + b0, o1 = a1 + b1;
            float ss = (o0[0] * o0[0] + o0[1] * o0[1]) + (o0[2] * o0[2] + o0[3] * o0[3]) + (o1[0] * o1[0] + o1[1] * o1[1]) + (o1[2] * o1[2] + o1[3] * o1[3]);
            ss += __shfl_xor(ss, 1); ss += __shfl_xor(ss, 2); ss += __shfl_xor(ss, 4); ss += __shfl_xor(ss, 8);
            const float rinv = rsqrtf(ss * (1.f / 128.f) + EPS);
            u32x4* gp = (u32x4*)(QG + m * 1024 + 512 + lane * 8);
            const u32x4 gw = *gp;
            float y[8];
#pragma unroll
            for (int e = 0; e < 8; ++e) { const float gv = (e & 1) ? __uint_as_float(gw[e >> 1] & 0xffff0000u) : __uint_as_float(gw[e >> 1] << 16);
                const float ov = e < 4 ? o0[e] : o1[e - 4], gg = e < 4 ? gn0[e] : gn1[e - 4]; y[e] = ov * rinv * gg * siluf(gv); }
            u32x4 w; w.x = pk2(y[0], y[1]); w.y = pk2(y[2], y[3]); w.z = pk2(y[4], y[5]); w.w = pk2(y[6], y[7]);
            *gp = w;
        }
        {
            float on[2][8];
#pragma unroll
            for (int mp = 0; mp < 2; ++mp) {
                const float2 ml0 = *(const float2*)(ML + (((size_t)(0 + mp) * M + m) * 4 + h) * 2), ml1 = *(const float2*)(ML + (((size_t)(2 + mp) * M + m) * 4 + h) * 2);
                const float mx = fmaxf(ml0.x, ml1.x);
                const float w0 = ml0.y * __builtin_amdgcn_exp2f(ml0.x - mx), w1 = ml1.y * __builtin_amdgcn_exp2f(ml1.x - mx);
                const float iw = __builtin_amdgcn_rcpf(w0 + w1);
                const u32x4 p0 = *(const u32x4*)((const bf16_t*)(a.ws + (mp == 0 ? WS_PO0 : WS_PO1)) + off), p1 = *(const u32x4*)((const bf16_t*)(a.ws + (mp == 0 ? WS_PO2 : WS_PO3)) + off);
#pragma unroll
                for (int e = 0; e < 8; ++e) { const float x0 = (e & 1) ? __uint_as_float(p0[e >> 1] & 0xffff0000u) : __uint_as_float(p0[e >> 1] << 16), x1 = (e & 1) ? __uint_as_float(p1[e >> 1] & 0xffff0000u) : __uint_as_float(p1[e >> 1] << 16);
                    on[mp][e] = (w0 * x0 + w1 * x1) * iw; }
            }
            float dd[8]; float ss = 0.f;
#pragma unroll
            for (int e = 0; e < 8; ++e) { dd[e] = on[0][e] - lam * on[1][e]; ss += dd[e] * dd[e]; }
            ss += __shfl_xor(ss, 1); ss += __shfl_xor(ss, 2); ss += __shfl_xor(ss, 4); ss += __shfl_xor(ss, 8);
            const float rinv = rsqrtf(ss * (1.f / 128.f) + EPS) * 0.8f;
            u32x4 w; w.x = pk2(dd[0] * rinv * sg0[0], dd[1] * rinv * sg0[1]); w.y = pk2(dd[2] * rinv * sg0[2], dd[3] * rinv * sg0[3]);
            w.z = pk2(dd[4] * rinv * sg1[0], dd[5] * rinv * sg1[1]); w.w = pk2(dd[6] * rinv * sg1[2], dd[7] * rinv * sg1[3]);
            *(u32x4*)(QG + m * 1024 + lane * 8) = w;
        }
    }
}

__device__ __forceinline__ void ph_topk(ArgsRef a, unsigned* lds) {
    const int tix_ = tid_fresh();
    const float* aff = (const float*)(a.ws + WS_AFF); int* IDXL = (int*)(a.ws + WS_IDXL); float* GATEL = (float*)(a.ws + WS_GATEL); int* SLOT = (int*)(a.ws + WS_SLOT);
    unsigned* hist = lds;
    unsigned* shp = lds + 2048;
    unsigned* wsum = lds + 2052;
    unsigned* wsum2 = lds + 2060;
    unsigned* csum = lds + 2068;
    const int t = tix_, lane = t & 63, w = t >> 6;
    for (int it = blockIdx.x; it < 32; it += gridDim.x) {
        const int e = it & 15, b = it >> 4;
        unsigned key[16];
#pragma unroll
        for (int i = 0; i < 16; ++i) key[i] = __float_as_uint(aff[((size_t)b * L + t * 16 + i) * 16 + e]);
        unsigned prefix = 0, need = 1024;
        for (int pass = 0; pass < 4; ++pass) {
            const int shift = 24 - 8 * pass;
            __syncthreads();
            for (int i = t; i < 2048; i += NT) hist[i] = 0;
            __syncthreads();
            const unsigned himask = pass == 0 ? 0u : (0xffffffffu << (shift + 8));
#pragma unroll
            for (int i = 0; i < 16; ++i) if ((key[i] & himask) == prefix) atomicAdd(&hist[w * 256 + ((key[i] >> shift) & 255)], 1u);
            __syncthreads();
            unsigned hsum = 0, cum = 0;
            if (t < 256) {
#pragma unroll
                for (int ww = 0; ww < 8; ++ww) hsum += hist[ww * 256 + 255 - t];
                cum = hsum;
#pragma unroll
                for (int o = 1; o < 64; o <<= 1) { const unsigned x1 = __shfl_up(cum, o); if (lane >= o) cum += x1; }
                if (lane == 63) csum[w] = cum;
            }
            __syncthreads();
            if (t < 256) {
                unsigned off = 0;
                for (int ww = 0; ww < w; ++ww) off += csum[ww];
                cum += off;
                if (cum >= need && cum - hsum < need) { shp[0] = prefix | ((unsigned)(255 - t) << shift); shp[1] = need - (cum - hsum); }
            }
            __syncthreads();
            prefix = shp[0]; need = shp[1];
        }
        const unsigned thr = prefix;
        unsigned ngt = 0, neq = 0;
#pragma unroll
        for (int i = 0; i < 16; ++i) { ngt += key[i] > thr; neq += key[i] == thr; }
        unsigned sg = ngt, se = neq;
#pragma unroll
        for (int o = 1; o < 64; o <<= 1) { const unsigned x1 = __shfl_up(sg, o), x2 = __shfl_up(se, o); if (lane >= o) { sg += x1; se += x2; } }
        __syncthreads();
        if (lane == 63) { wsum[w] = sg; wsum2[w] = se; }
        __syncthreads();
        unsigned og = 0, oe = 0, total_gt = 0;
        for (int i = 0; i < 8; ++i) { if (i < w) { og += wsum[i]; oe += wsum2[i]; } total_gt += wsum[i]; }
        unsigned pg = og + sg - ngt, pe = oe + se - neq;
        const int grp = b * 16 + e;
#pragma unroll
        for (int i = 0; i < 16; ++i) {
            const int tok = t * 16 + i; int slot = -1;
            if (key[i] > thr) { slot = (int)pg; ++pg; }
            else if (key[i] == thr) { if (pe < need) slot = (int)(total_gt + pe); ++pe; }
            SLOT[((size_t)b * L + tok) * 16 + e] = slot;
            if (slot >= 0) { IDXL[grp * 1024 + slot] = tok; GATEL[grp * 1024 + slot] = __uint_as_float(key[i]); }
        }
    }
}

__device__ __forceinline__ void ph_final(ArgsRef a) {
    const int tix_ = tid_fresh();
    float* xio = a.out; const bf16_t* YE = (const bf16_t*)(a.ws + WS_YE); const int* SLOT = (const int*)(a.ws + WS_SLOT); const float* mod = (const float*)(a.ws + WS_MOD);
    const bf16_t* zrow = (const bf16_t*)(a.ws + WS_CTL + 60 * 1024);
    const int lane = tix_ & 63;
    const int row0 = blockIdx.x * 8 + (tix_ >> 6), rstep = gridDim.x * 8;
    int slotn = -1; float4 xn[4];
    if (row0 < M) { if (lane < 16) slotn = SLOT[(size_t)row0 * 16 + lane];
#pragma unroll
        for (int j = 0; j < 4; ++j) xn[j] = *(const float4*)(xio + (size_t)row0 * D + 4 * lane + 256 * j); }
    for (int row = row0; row < M; row += rstep) {
        const int b = row / L;
        const int slotv = slotn; float4 xc[4];
#pragma unroll
        for (int j = 0; j < 4; ++j) xc[j] = xn[j];
        ushort4 yv[16][4];
#pragma unroll
        for (int e = 0; e < 16; ++e) {
            const int slot = __builtin_amdgcn_readlane(slotv, e);
            const bf16_t* yr = slot >= 0 ? YE + ((size_t)(b * 16 + e) * 1024 + slot) * 1024 : zrow;
#pragma unroll
            for (int j = 0; j < 4; ++j) yv[e][j] = *(const ushort4*)(yr + 4 * lane + 256 * j);
        }
        { const int rn = row + rstep; if (rn < M) { if (lane < 16) slotn = SLOT[(size_t)rn * 16 + lane];
#pragma unroll
            for (int j = 0; j < 4; ++j) xn[j] = *(const float4*)(xio + (size_t)rn * D + 4 * lane + 256 * j); } }
        float acc[16];
#pragma unroll
        for (int i = 0; i < 16; ++i) acc[i] = 0.f;
#pragma unroll
        for (int e = 0; e < 16; ++e)
#pragma unroll
            for (int j = 0; j < 4; ++j) { acc[4 * j] += bf2f(yv[e][j].x); acc[4 * j + 1] += bf2f(yv[e][j].y); acc[4 * j + 2] += bf2f(yv[e][j].z); acc[4 * j + 3] += bf2f(yv[e][j].w); }
        const float* gt2 = mod + b * 6144 + 5120;
        float y[16]; float ss = 0.f;
#pragma unroll
        for (int j = 0; j < 4; ++j) {
            const int k0 = 4 * lane + 256 * j;
            const float4 xv = xc[j], gg = *(const float4*)(gt2 + k0);
            y[4 * j] = xv.x + gg.x * acc[4 * j]; y[4 * j + 1] = xv.y + gg.y * acc[4 * j + 1]; y[4 * j + 2] = xv.z + gg.z * acc[4 * j + 2]; y[4 * j + 3] = xv.w + gg.w * acc[4 * j + 3];
            ss += y[4 * j] * y[4 * j] + y[4 * j + 1] * y[4 * j + 1] + y[4 * j + 2] * y[4 * j + 2] + y[4 * j + 3] * y[4 * j + 3];
        }
        ss = wave_sum(ss);
        const float rinv = rsqrtf(ss * (1.f / D) + EPS);
#pragma unroll
        for (int j = 0; j < 4; ++j) {
            const int k0 = 4 * lane + 256 * j; const float4 gg = *(const float4*)(a.final_g + k0);
            float4 o; o.x = y[4 * j] * rinv * gg.x; o.y = y[4 * j + 1] * rinv * gg.y; o.z = y[4 * j + 2] * rinv * gg.z; o.w = y[4 * j + 3] * rinv * gg.w;
            *(float4*)(xio + (size_t)row * D + k0) = o;
        }
    }
}

__device__ __forceinline__ ArgsRef fresh_args() {
    const unsigned long long p = (unsigned long long)__builtin_amdgcn_kernarg_segment_ptr();
    unsigned lo = (unsigned)p, hi = (unsigned)(p >> 32);
    asm volatile("" : "+s"(lo), "+s"(hi));
    lo = __builtin_amdgcn_readfirstlane(lo); hi = __builtin_amdgcn_readfirstlane(hi);
    return *(const __attribute__((address_space(4))) Args*)(((unsigned long long)hi << 32) | lo);
}
__global__ void __launch_bounds__(NT, 2) fwd_megakernel(Args a_in) {
#define A_ fresh_args()
    extern __shared__ __attribute__((aligned(16))) unsigned char lds_raw[];
    float* ldsf = (float*)lds_raw;
    volatile LAS unsigned* MISC = (volatile LAS unsigned*)((LAS unsigned char*)lds_raw + LDS_MISC);
    if (threadIdx.x < 64) MISC[threadIdx.x] = 0u;
    __syncthreads();
    XcdBarrier bar = xcd_barrier_post((unsigned*)(A_.ws + WS_CTL), MISC + 8);
#define GRID_BAR() xcd_barrier(bar)
    LAS unsigned char* lds3 = (LAS unsigned char*)lds_raw;
    ph_mod(A_, ldsf);
    ph_convert_small(A_, lds_raw);
    GRID_BAR();
    ph_norm<0>(A_, ldsf);
    GRID_BAR();
    { ArgsRef a = A_; unsigned char* ws = a.ws; pg8::Gemm g{(const bf16_t*)(ws + WS_H1), (const bf16_t*)(ws + WS_WIN_T), R, 3584, D, 0, 0, nullptr, 1, 0}; pg8::StaticOrder S; S.init(R, 3584, (int)gridDim.x, (int)blockIdx.x);
      EpiInProj e{(bf16_t*)(ws + WS_QG), (bf16_t*)(ws + WS_K), (bf16_t*)(ws + WS_V), (bf16_t*)(ws + WS_GQKV), (const float*)(ws + WS_ROPE)};
      pg8::gemm_phase<EpiInProj, pg8::StaticOrder, true, true>(lds3, g, S, e); }
    GRID_BAR();
    gdn::prep(A_, lds_raw);
    GRID_BAR();
    ph_gdn_scan(A_, lds_raw);
    ph_attn(A_, lds_raw);
    GRID_BAR();
    ph_gdn_out(A_);
    GRID_BAR();
    { ArgsRef a = A_; unsigned char* ws = a.ws; pg8::Gemm g{(const bf16_t*)(ws + WS_QG), (const bf16_t*)(ws + WS_WOUT_T), M, D, D, 0, 0, nullptr, 1, 0}; pg8::StaticOrder S; S.init(M, D, (int)gridDim.x, (int)blockIdx.x);
      EpiOutProj e{a.x, (const float*)(ws + WS_MOD), a.out};
      pg8::gemm_phase<EpiOutProj, pg8::StaticOrder, true, true>(lds3, g, S, e); }
    GRID_BAR();
    ph_norm<1>(A_, ldsf);
    GRID_BAR();
    ph_topk(A_, (unsigned*)ldsf);
    ph_fill_wdown(A_, lds_raw);
    GRID_BAR();
    { ArgsRef a = A_; unsigned char* ws = a.ws; pg8::Gemm g{(const bf16_t*)(ws + WS_H2), (const bf16_t*)(ws + WS_WGU), 32 * 1024, 2048, D, 4, 2048, (const int*)(ws + WS_IDXL), 64, (size_t)L * D * 2};   pg8::StaticOrder S; S.init(32 * 1024, 2048, (int)gridDim.x, (int)blockIdx.x);
      EpiMoeUp e{(bf16_t*)(ws + WS_HID)};
      pg8::gemm_phase<EpiMoeUp, pg8::StaticOrder, true, true, true>(lds3, g, S, e); }
    GRID_BAR();
    { ArgsRef a = A_; unsigned char* ws = a.ws; pg8::Gemm g{(const bf16_t*)(ws + WS_HID), (const bf16_t*)(ws + WS_WD), 32 * 1024, 1024, 1024, 4, 1024, nullptr, 1, 0}; pg8::StaticOrder S; S.init(32 * 1024, 1024, (int)gridDim.x, (int)blockIdx.x);
      EpiMoeDown e{(bf16_t*)(ws + WS_YE), (const float*)(ws + WS_GATEL)};
      pg8::gemm_phase<EpiMoeDown, pg8::StaticOrder, true, true>(lds3, g, S, e); }
    GRID_BAR();
    ph_final(A_);
}

extern "C" void kernel_launch(void* const* d_in, const int* in_sizes, int n_in, void* d_out, int out_size, void* d_ws, size_t ws_size, hipStream_t stream) {
    static int grid = 0;
    if (grid == 0) {
        if (n_in != 24 || out_size != M * D || ws_size < WS_END) { fprintf(stderr, "kernel_launch: unexpected sizes n_in %d out %d ws %zu\n", n_in, out_size, ws_size); grid = -1; return; }
        int dev = 0, cus = 0;
        if (hipGetDevice(&dev) != hipSuccess || hipDeviceGetAttribute(&cus, hipDeviceAttributeMultiprocessorCount, dev) != hipSuccess) { grid = -1; return; }
        if (hipFuncSetAttribute((const void*)fwd_megakernel, hipFuncAttributeMaxDynamicSharedMemorySize, LDS_BYTES) != hipSuccess) { fprintf(stderr, "kernel_launch: hipFuncSetAttribute failed\n"); grid = -1; return; }
        int per_cu = 0;
        if (hipOccupancyMaxActiveBlocksPerMultiprocessor(&per_cu, (const void*)fwd_megakernel, NT, LDS_BYTES) != hipSuccess || per_cu < 1) { fprintf(stderr, "kernel_launch: occupancy query says %d\n", per_cu); }
        (void)hipGetLastError();
        grid = cus;
    }
    if (grid < 0) return;
    (void)hipMemsetAsync((char*)d_ws + WS_CTL, 0, CTL_BYTES, stream);
    Args a{};
    const float** p = (const float**)&a;
    for (int i = 0; i < 24; ++i) p[i] = (const float*)d_in[i];
    a.out = (float*)d_out; a.ws = (unsigned char*)d_ws;
    hipLaunchKernelGGL(fwd_megakernel, dim3(grid), dim3(NT), LDS_BYTES, stream, a);
}
```

```cpp
#include <hip/hip_runtime.h>
#include <stdint.h>
#include <stdio.h>

typedef unsigned short bf16_t;
constexpr int D = 1024, NB = 2, L = 8192, LC = 256, LT = L + LC, R = NB * LT, M = NB * L;
constexpr int INC = 3600;
constexpr int NCH = LT / 64;
constexpr int NCI = 2 * NB * 4 * NCH;
constexpr float EPS = 1e-6f;
constexpr size_t MiB = 1u << 20;
constexpr int NT = 512;
constexpr size_t WS_CTL = 0, CTL_BYTES = 64 * 1024;
constexpr size_t WS_MOD = 128 * 1024;
constexpr size_t WS_ROPE = 256 * 1024;
constexpr size_t WS_WOUT_T = 1 * MiB;
constexpr size_t WS_AFF = 1 * MiB;
constexpr size_t WS_SLOT = 2 * MiB;
constexpr size_t WS_IDXL = 3 * MiB;
constexpr size_t WS_GATEL = 3 * MiB + 256 * 1024;
constexpr size_t WS_G = 4 * MiB;
constexpr size_t WS_BETA = 5 * MiB;
constexpr size_t WS_GL = 6 * MiB;
constexpr size_t WS_AB = 7 * MiB;
constexpr size_t WS_H1 = 10 * MiB;
constexpr size_t WS_WN = 10 * MiB;
constexpr size_t WS_QG = 43 * MiB;
constexpr size_t WS_K = 75 * MiB;
constexpr size_t WS_V = 92 * MiB;
constexpr size_t WS_GQKV = 109 * MiB;
constexpr size_t WS_QD = 159 * MiB;
constexpr size_t WS_AQK = 192 * MiB;
constexpr size_t WS_UB = 209 * MiB;
constexpr size_t WS_KDT = 242 * MiB;
constexpr size_t WS_WIN_T = 292 * MiB;
constexpr size_t WS_PO0 = 109 * MiB, WS_PO1 = 125 * MiB, WS_PO2 = 141 * MiB, WS_PO3 = 275 * MiB;
constexpr size_t WS_ML = 291 * MiB;
constexpr size_t WS_WD = 10 * MiB;
constexpr size_t WS_H2 = 43 * MiB;
constexpr size_t WS_XE = 75 * MiB;
constexpr size_t WS_YE = 75 * MiB;
constexpr size_t WS_HID = 139 * MiB;
constexpr size_t WS_WGU = 209 * MiB;
constexpr size_t WS_END = 299 * MiB;
constexpr int LDS_BYTES = 160 * 1024;
constexpr int LDS_MISC = LDS_BYTES - 256;

#define LAS __attribute__((address_space(3)))
__device__ __forceinline__ bf16_t f2bf(float f) { unsigned u = __float_as_uint(f); u += 0x7fffu + ((u >> 16) & 1u); return (bf16_t)(u >> 16); }
__device__ __forceinline__ float bf2f(bf16_t h) { return __uint_as_float(((unsigned)h) << 16); }
__device__ __forceinline__ float siluf(float x) { return x * __builtin_amdgcn_rcpf(1.f + __expf(-x)); }
__device__ __forceinline__ float wave_sum(float v) {
#pragma unroll
    for (int o = 1; o < 64; o <<= 1) v += __shfl_xor(v, o);
    return v;
}

typedef float f32x4 __attribute__((ext_vector_type(4)));
typedef float f32x2_cv __attribute__((ext_vector_type(2))); typedef __bf16 bf16x2_cv __attribute__((ext_vector_type(2)));
__device__ __forceinline__ unsigned cvt2bf(float lo, float hi) { f32x2_cv v = {lo, hi}; bf16x2_cv b = __builtin_convertvector(v, bf16x2_cv); return __builtin_bit_cast(unsigned, b); }
__device__ __forceinline__ int tid_fresh() { int t = threadIdx.x; asm volatile("" : "+v"(t)); return t; }
#define XB_TMO      128
#define XB_XCNT(j)  (256  + 64 * (j))
#define XB_XSUB(j)  (1280 + 64 * (j))
#define XB_XGEN(j)  (2304 + 64 * (j))
#define XB_TOP      3328
#define XB_TOPGEN   3392
#define XCD_BAR_WORDS 3456
#define XB_SPIN_CAP (1u << 22)
__device__ __forceinline__ unsigned xb_ld(unsigned* p)              { return __hip_atomic_load(p, __ATOMIC_RELAXED, __HIP_MEMORY_SCOPE_AGENT); }
__device__ __forceinline__ unsigned xb_add(unsigned* p, unsigned v) { return __hip_atomic_fetch_add(p, v, __ATOMIC_RELAXED, __HIP_MEMORY_SCOPE_AGENT); }
__device__ __forceinline__ unsigned xb_xcc_id() { return (unsigned)__builtin_amdgcn_s_getreg((3 << 11) | 20) & 0xFu; }
#define XB_SPIN(cond, bar) do { unsigned _sp = 0; while (cond) { __builtin_amdgcn_s_sleep(1); \
    if ((++_sp & 255u) == 0u) { if (xb_ld(&(bar)[XB_TMO])) break; if (_sp > XB_SPIN_CAP) { atomicAdd(&(bar)[XB_TMO], 1u); break; } } } } while (0)
struct XcdBarrier { unsigned* bar; unsigned x; volatile LAS unsigned* st; };
__device__ __forceinline__ XcdBarrier xcd_barrier_post(unsigned* bar, volatile LAS unsigned* st) {
    XcdBarrier b; b.bar = bar; b.x = xb_xcc_id(); b.st = st;
    if (threadIdx.x == 0) (void)xb_add(&bar[XB_XCNT(b.x)], 1u);
    return b;
}
__device__ __forceinline__ void xcd_barrier_complete(unsigned* bar, unsigned x, unsigned& nloc, unsigned& nx) {
    const unsigned G = gridDim.x * gridDim.y * gridDim.z;
    unsigned sum, cnt, mine, sp = 0u;
    for (;;) {
        sum = 0u; cnt = 0u; mine = 0u;
#pragma unroll
        for (unsigned j = 0; j < 16; ++j) { const unsigned c = xb_ld(&bar[XB_XCNT(j)]); sum += c; cnt += (c > 0u) ? 1u : 0u; mine = (j == x) ? c : mine; }
        if (sum == G) break;
        __builtin_amdgcn_s_sleep(1);
        if ((++sp & 255u) == 0u) { if (xb_ld(&bar[XB_TMO])) break; if (sp > XB_SPIN_CAP) { atomicAdd(&bar[XB_TMO], 1u); break; } }
    }
    nloc = mine > 0u ? mine : 1u; nx = cnt > 0u ? cnt : 1u;
}
__device__ __forceinline__ void xcd_barrier(const XcdBarrier& b) {
    asm volatile("s_waitcnt vmcnt(0)" ::: "memory");
    __syncthreads();
    if (threadIdx.x == 0) {
        unsigned* bar = b.bar;
        __builtin_amdgcn_s_waitcnt(0);
        unsigned nloc = b.st[0], nx = b.st[1];
        if (nloc == 0u) { xcd_barrier_complete(bar, b.x, nloc, nx); b.st[0] = nloc; b.st[1] = nx; }
        const unsigned old = xb_add(&bar[XB_XSUB(b.x)], 1u);
        const unsigned gen = old / nloc;
        if (old + 1u == (gen + 1u) * nloc) {
            __builtin_amdgcn_fence(__ATOMIC_RELEASE, "agent");
            asm volatile("s_waitcnt vmcnt(0)" ::: "memory");
            const unsigned og = xb_add(&bar[XB_TOP], 1u);
            const unsigned tg = og / nx;
            if (og + 1u == (tg + 1u) * nx) xb_add(&bar[XB_TOPGEN], 1u);
            else XB_SPIN(xb_ld(&bar[XB_TOPGEN]) == tg, bar);
            __builtin_amdgcn_fence(__ATOMIC_ACQUIRE, "agent");
            xb_add(&bar[XB_XGEN(b.x)], 1u);
            asm volatile("s_waitcnt vmcnt(0)" ::: "memory");
        } else {
            XB_SPIN(xb_ld(&bar[XB_XGEN(b.x)]) == gen, bar);
            __builtin_amdgcn_fence(__ATOMIC_ACQUIRE, "agent");
            asm volatile("s_waitcnt vmcnt(0)" ::: "memory");
        }
    }
    __syncthreads();
}

struct Args {
    const float *x, *c, *ctx, *c_ctx, *w_mod, *b_mod, *norm1_g, *w_in, *conv_w, *a_log, *dt_bias, *gdn_norm_g;
    const float *lq1, *lk1, *lq2, *lk2, *subg, *w_out, *norm2_g, *w_router, *w_gate, *w_up, *w_down, *final_g;
    float* out; unsigned char* ws;
};
typedef const __attribute__((address_space(4))) Args& ArgsRef;

__device__ __forceinline__ void ph_mod(ArgsRef a, float* lds) {
    const int tix_ = tid_fresh();
    float* s = lds;
    float* red = lds + 3072;
    float* mod = (float*)(a.ws + WS_MOD);
    const int t = tix_;
    for (int i = t; i < 1024; i += NT) { s[i] = siluf(a.c[i]); s[1024 + i] = siluf(a.c[1024 + i]); s[2048 + i] = siluf(a.c_ctx[i]); }
    __syncthreads();
    const int rq = t & 7, kg = t >> 3;
    for (int it = blockIdx.x; it < 256; it += gridDim.x) {
        const int n0 = it * 24;
        f32x4 a0 = {0.f, 0.f, 0.f, 0.f}, a1 = a0, a2 = a0;
        if (rq < 6) {
            f32x4 wv[16];
#pragma unroll
            for (int j = 0; j < 16; ++j) wv[j] = *(const f32x4*)(a.w_mod + (size_t)(kg + 64 * j) * 6144 + n0 + 4 * rq);
#pragma unroll
            for (int j = 0; j < 16; ++j) { const int k = kg + 64 * j; a0 += wv[j] * s[k]; a1 += wv[j] * s[1024 + k]; a2 += wv[j] * s[2048 + k]; }
#pragma unroll
            for (int e = 0; e < 4; ++e) { red[(kg * 3 + 0) * 24 + 4 * rq + e] = a0[e]; red[(kg * 3 + 1) * 24 + 4 * rq + e] = a1[e]; red[(kg * 3 + 2) * 24 + 4 * rq + e] = a2[e]; }
        }
        __syncthreads();
        if (t < 72) {
            const int v = t / 24, cc = t % 24; float acc = a.b_mod[n0 + cc];
            for (int g = 0; g < 64; ++g) acc += red[(g * 3 + v) * 24 + cc];
            mod[v * 6144 + n0 + cc] = acc;
        }
        __syncthreads();
    }
    if (blockIdx.x == 0 && t == 0) {
        float s1 = 0.f, s2 = 0.f;
        for (int i = 0; i < 64; ++i) { s1 += a.lq1[i] * a.lk1[i]; s2 += a.lq2[i] * a.lk2[i]; }
        mod[3 * 6144] = expf(s1) - expf(s2) + 0.2f;
    }
}

template <int MODE>
__device__ __forceinline__ void ph_norm(ArgsRef a, float* lds) {
    const int tix_ = tid_fresh();
    {
        const float* wsrc0 = MODE == 0 ? a.w_in + 3584 : a.w_router; const int wld0 = MODE == 0 ? INC : 16;
        __syncthreads();
        for (int k = tix_; k < 1024; k += NT) {
            const float4* wr = (const float4*)(wsrc0 + (size_t)k * wld0);
            const float4 w0 = wr[0], w1 = wr[1], w2 = wr[2], w3 = wr[3];
            lds[0 * 1024 + k] = w0.x; lds[1 * 1024 + k] = w0.y; lds[2 * 1024 + k] = w0.z; lds[3 * 1024 + k] = w0.w;
            lds[4 * 1024 + k] = w1.x; lds[5 * 1024 + k] = w1.y; lds[6 * 1024 + k] = w1.z; lds[7 * 1024 + k] = w1.w;
            lds[8 * 1024 + k] = w2.x; lds[9 * 1024 + k] = w2.y; lds[10 * 1024 + k] = w2.z; lds[11 * 1024 + k] = w2.w;
            lds[12 * 1024 + k] = w3.x; lds[13 * 1024 + k] = w3.y; lds[14 * 1024 + k] = w3.z; lds[15 * 1024 + k] = w3.w;
        }
        __syncthreads();
    }
    const float* mod = (const float*)(a.ws + WS_MOD);
    bf16_t* out = (bf16_t*)(a.ws + (MODE == 0 ? WS_H1 : WS_H2));
    float* aff = (float*)(a.ws + WS_AFF);
    const float* g = MODE == 0 ? a.norm1_g : a.norm2_g;
    const int lane = tix_ & 63;
    const int nrows = MODE == 0 ? R : M;
    for (int row = blockIdx.x * 8 + (tix_ >> 6); row < nrows; row += gridDim.x * 8) {
        const float* src; int mv;
        if (MODE == 0) { const int b = row / LT, j = row % LT; if (j < LC) { src = a.ctx + ((size_t)b * LC + j) * D; mv = 2; } else { src = a.x + ((size_t)b * L + (j - LC)) * D; mv = b; } }
        else { src = a.out + (size_t)row * D; mv = row / L; }
        const float* sh = mod + mv * 6144 + (MODE == 0 ? 0 : 3072);
        const float* sc = sh + 1024;
        float4 v[4]; float ss = 0.f;
#pragma unroll
        for (int j = 0; j < 4; ++j) { v[j] = *(const float4*)(src + 4 * lane + 256 * j); ss += v[j].x * v[j].x + v[j].y * v[j].y + v[j].z * v[j].z + v[j].w * v[j].w; }
        ss = wave_sum(ss);
        const float rinv = rsqrtf(ss * (1.f / D) + EPS);
        float y[16];
#pragma unroll
        for (int j = 0; j < 4; ++j) {
            const int k0 = 4 * lane + 256 * j;
            const float4 gg = *(const float4*)(g + k0), s1 = *(const float4*)(sc + k0), s0 = *(const float4*)(sh + k0);
            y[4 * j + 0] = v[j].x * rinv * gg.x * (1.f + s1.x) + s0.x;
            y[4 * j + 1] = v[j].y * rinv * gg.y * (1.f + s1.y) + s0.y;
            y[4 * j + 2] = v[j].z * rinv * gg.z * (1.f + s1.z) + s0.z;
            y[4 * j + 3] = v[j].w * rinv * gg.w * (1.f + s1.w) + s0.w;
            ushort4 o; o.x = f2bf(y[4 * j + 0]); o.y = f2bf(y[4 * j + 1]); o.z = f2bf(y[4 * j + 2]); o.w = f2bf(y[4 * j + 3]);
            *(ushort4*)(out + (size_t)row * D + k0) = o;
        }
        {
            float lg[16];
#pragma unroll
            for (int e = 0; e < 16; ++e) {
                float acc = 0.f;
#pragma unroll
                for (int j = 0; j < 4; ++j) { const float4 w = *(const float4*)(lds + e * 1024 + 4 * lane + 256 * j);
                    acc += y[4 * j] * w.x + y[4 * j + 1] * w.y + y[4 * j + 2] * w.z + y[4 * j + 3] * w.w; }
                lg[e] = acc;
                if ((e & 3) == 3) asm volatile("" ::: "memory");
            }
            float v8[8], v4[4], v2[2], mine;
            { const bool up = lane & 32;
#pragma unroll
              for (int i = 0; i < 8; ++i) { const float keep = up ? lg[8 + i] : lg[i], send = up ? lg[i] : lg[8 + i]; v8[i] = keep + __shfl_xor(send, 32); } }
            { const bool up = lane & 16;
#pragma unroll
              for (int i = 0; i < 4; ++i) { const float keep = up ? v8[4 + i] : v8[i], send = up ? v8[i] : v8[4 + i]; v4[i] = keep + __shfl_xor(send, 16); } }
            { const bool up = lane & 8;
#pragma unroll
              for (int i = 0; i < 2; ++i) { const float keep = up ? v4[2 + i] : v4[i], send = up ? v4[i] : v4[2 + i]; v2[i] = keep + __shfl_xor(send, 8); } }
            { const bool up = lane & 4; const float keep = up ? v2[1] : v2[0], send = up ? v2[0] : v2[1]; mine = keep + __shfl_xor(send, 4); }
            mine += __shfl_xor(mine, 2); mine += __shfl_xor(mine, 1);
            const int ecol = ((lane >> 5) & 1) * 8 + ((lane >> 4) & 1) * 4 + ((lane >> 3) & 1) * 2 + ((lane >> 2) & 1);
            if (MODE == 0) {
                if ((lane & 3) == 0) ((float*)(a.ws + WS_AB))[(size_t)row * 16 + ecol] = mine;
            } else {
                float mx = mine;
                mx = fmaxf(mx, __shfl_xor(mx, 4)); mx = fmaxf(mx, __shfl_xor(mx, 8)); mx = fmaxf(mx, __shfl_xor(mx, 16)); mx = fmaxf(mx, __shfl_xor(mx, 32));
                const float ex = expf(mine - mx);
                float sum = ex;
                sum += __shfl_xor(sum, 4); sum += __shfl_xor(sum, 8); sum += __shfl_xor(sum, 16); sum += __shfl_xor(sum, 32);
                if ((lane & 3) == 0) aff[(size_t)row * 16 + ecol] = ex / sum;
            }
        }
    }
}

namespace pg8 {
#define PG8_LAS __attribute__((address_space(3)))
typedef unsigned short bf16_t;
typedef short bf16x8 __attribute__((ext_vector_type(8)));
typedef float f32x4 __attribute__((ext_vector_type(4)));
typedef unsigned u32x4 __attribute__((ext_vector_type(4)));
constexpr int BM = 256, BK = 64, HALF = 128, HTB = HALF * BK * 2  , STAGE_BYTES = 8 * HTB, NXCD = 8, WGM = 8;

__host__ __device__ __forceinline__ int lds_byte(int r, int c) { const int st = (r >> 4) * 2 + (c >> 5), rr = r & 15, cc = c & 31, ob = rr * 64 + cc * 2; return st * 1024 + (ob ^ (((ob >> 9) & 1) << 5)); }
__host__ __device__ __forceinline__ void stage_rc(int b, int& R, int& C) { const int st = b / 1024, sb = b % 1024, swz = sb ^ (((sb >> 9) & 1) << 5); R = (st >> 1) * 16 + swz / 64; C = (st & 1) * 32 + (swz % 64) / 2; }
__host__ __device__ __forceinline__ int perm32(int rho) { const int n = rho >> 4, i = rho & 15; return 8 * (i >> 2) + 4 * n + (i & 3); }

struct Unit { int pm, pn; };
struct Gemm { const bf16_t* A; const bf16_t* Bt; int M, N, K; int grp_tiles, grp_rows; const int* idx; int tpb; size_t bstride;
    __host__ __device__ __forceinline__ size_t boff(const Unit& u) const { return ((size_t)(grp_tiles ? ((u.pm / grp_tiles) & 15) * grp_rows : 0) + (size_t)u.pn * BM) * (size_t)K * 2; } };

struct StaticOrder {
    int nM, nN, nwg, G, c;
    __host__ __device__ void init(int M, int N, int G_, int c_) { nM = M / BM; nN = N / BM; nwg = nM * nN; G = G_; c = c_; }
    __host__ __device__ bool next(int i, Unit& u) const {
        const long L = (long)i * G + c; if (L >= nwg) return false;
        int wgid = (int)L; { const int q = nwg / NXCD, r = nwg % NXCD, xcd = wgid % NXCD, off = wgid / NXCD; wgid = (xcd < r ? xcd * (q + 1) : r * (q + 1) + (xcd - r) * q) + off; }
        const int nig = WGM * nN, gid = wgid / nig, fm = gid * WGM, gsz = (nM - fm) < WGM ? (nM - fm) : WGM;
        u.pm = fm + ((wgid % nig) % gsz); u.pn = (wgid % nig) / gsz; return true;
    }
    __device__ __forceinline__ void a_ready(const Unit&) const {}
    __device__ __forceinline__ void done(const Unit&) const {}
};

__device__ __forceinline__ unsigned cvt_pk_bf16(float lo, float hi) { return cvt2bf(lo, hi); }
typedef float f32x2 __attribute__((ext_vector_type(2)));

template <class Epi, class Sched, bool ALIGN_EPI = false, bool SP2 = false, bool GATHER = false>
__device__ __forceinline__ void gemm_phase(PG8_LAS unsigned char* lds, const Gemm g, const Sched& S, const Epi& E) {
    const int tid = tid_fresh(), wid = __builtin_amdgcn_readfirstlane(tid >> 6), lane = tid & 63, wr = wid >> 2, wc = wid & 3, fr = lane & 15, fq = lane >> 4;
    const int K = g.K, nt = K / BK;
    unsigned voffA[2], voffB[2];
#pragma unroll
    for (int i = 0; i < 2; ++i) { int R, C; stage_rc(tid * 16 + i * 8192, R, C); const int Rb = Epi::PERM ? ((R & ~31) + perm32(R & 31)) : R;
        voffA[i] = (unsigned)(R * K + C) * 2u; voffB[i] = (unsigned)(Rb * K + C) * 2u; }
    const size_t kstep = (size_t)(BK * 2);
    const size_t hstep = (size_t)HALF * K * 2;
    const size_t tstep = 2 * hstep;
    const unsigned ldsw = (unsigned)wid * 1024u;
    const int aoff = lds_byte(wr * 64 + fr, fq * 8), boff = lds_byte(wc * 32 + fr, fq * 8);
#define PG8_SA(b, h) (((b) * 2 + (h)) * HTB)
#define PG8_SB(b, h) ((4 + (b) * 2 + (h)) * HTB)
#define PG8_STAGE(bufoff, gbase, voff) do { _Pragma("unroll") for (int _i = 0; _i < 2; ++_i) \
        __builtin_amdgcn_global_load_lds((const unsigned*)((const char*)(gbase) + (voff)[_i]), (PG8_LAS unsigned*)(lds + (bufoff) + ldsw + _i * 8192), 16, 0, 0); } while (0)
#define PG8_LDA(dst, b, h) do { _Pragma("unroll") for (int m = 0; m < 4; ++m) _Pragma("unroll") for (int k = 0; k < 2; ++k) dst[m][k] = *(const PG8_LAS bf16x8*)(lds + PG8_SA(b, h) + aoff + m * 2048 + k * 1024); } while (0)
#define PG8_LDB(dst, b, h) do { _Pragma("unroll") for (int n = 0; n < 2; ++n) _Pragma("unroll") for (int k = 0; k < 2; ++k) dst[n][k] = *(const PG8_LAS bf16x8*)(lds + PG8_SB(b, h) + boff + n * 2048 + k * 1024); } while (0)
#define PG8_MMA(ai, bj, At, Bt) do { __builtin_amdgcn_s_setprio(1); _Pragma("unroll") for (int m = 0; m < 4; ++m) _Pragma("unroll") for (int n = 0; n < 2; ++n) _Pragma("unroll") for (int k = 0; k < 2; ++k) \
        acc[ai][bj][m][n] = __builtin_amdgcn_mfma_f32_16x16x32_bf16(Bt[n][k], At[m][k], acc[ai][bj][m][n], 0, 0, 0); __builtin_amdgcn_s_setprio(0); } while (0)
#define PG8_WAIT_V(n) asm volatile("s_waitcnt vmcnt(" #n ")" ::: "memory")
#define PG8_WAIT_L(n) asm volatile("s_waitcnt lgkmcnt(" #n ")" ::: "memory")
#define PG8_BAR __builtin_amdgcn_s_barrier()
#define PG8_SCHED __builtin_amdgcn_sched_barrier(0)
    Unit cur, nxt; int ui = 0;
    if (!S.next(0, cur)) return;
    f32x4 acc[2][2][4][2];
#pragma unroll
    for (int a = 0; a < 2; ++a)
#pragma unroll
        for (int b = 0; b < 2; ++b)
#pragma unroll
            for (int m = 0; m < 4; ++m)
#pragma unroll
                for (int n = 0; n < 2; ++n) acc[a][b][m][n] = (f32x4){0.f, 0.f, 0.f, 0.f};
    bf16x8 At[4][2], B0[2][2], B1[2][2];
    unsigned vA0[2], vA1[2], nvA0[2], nvA1[2];
    int rA[2], cA2[2];
#pragma unroll
    for (int i = 0; i < 2; ++i) { int R, C; stage_rc(tid * 16 + i * 8192, R, C); rA[i] = R; cA2[i] = C * 2; }
#define PG8_AOFF(u_, o0_, o1_) do { _Pragma("unroll") for (int i_ = 0; i_ < 2; ++i_) { \
        if (GATHER) { o0_[i_] = (unsigned)g.idx[(u_).pm * BM + rA[i_]] * (unsigned)(K * 2) + cA2[i_]; o1_[i_] = (unsigned)g.idx[(u_).pm * BM + HALF + rA[i_]] * (unsigned)(K * 2) + cA2[i_]; } \
        else { o0_[i_] = voffA[i_]; o1_[i_] = voffA[i_] + (unsigned)hstep; } } } while (0)
#define PG8_ABASE(u_) (GATHER ? (const char*)g.A + (size_t)((u_).pm / g.tpb) * g.bstride : (const char*)g.A + (size_t)(u_).pm * tstep)
    PG8_AOFF(cur, vA0, vA1);
    const char* cA = PG8_ABASE(cur); const char* cB = (const char*)g.Bt + g.boff(cur);
    S.a_ready(cur);
    if constexpr (SP2) {
        PG8_STAGE(PG8_SB(0, 0), cB, voffB); PG8_STAGE(PG8_SB(0, 1), cB + hstep, voffB); PG8_STAGE(PG8_SA(0, 0), cA, vA0); PG8_STAGE(PG8_SA(0, 1), cA, vA1);
        if (wr == 1) PG8_BAR;
        PG8_WAIT_V(2); PG8_BAR;
        PG8_STAGE(PG8_SB(1, 0), cB + kstep, voffB); PG8_STAGE(PG8_SA(1, 0), cA + kstep, vA0); PG8_STAGE(PG8_SB(1, 1), cB + hstep + kstep, voffB);
        PG8_WAIT_V(6); PG8_BAR;
    } else {
        PG8_STAGE(PG8_SB(0, 0), cB, voffB); PG8_STAGE(PG8_SA(0, 0), cA, vA0); PG8_STAGE(PG8_SB(0, 1), cB + hstep, voffB); PG8_STAGE(PG8_SA(0, 1), cA, vA1);
        if (wr == 1) PG8_BAR;
        PG8_WAIT_V(4); PG8_BAR;
        PG8_STAGE(PG8_SB(1, 0), cB + kstep, voffB); PG8_STAGE(PG8_SA(1, 0), cA + kstep, vA0); PG8_STAGE(PG8_SB(1, 1), cB + hstep + kstep, voffB);
        PG8_WAIT_V(6); PG8_BAR;
    }
    for (;;) {
        const bool has_next = S.next(ui + 1, nxt);
        const char* nA = has_next ? PG8_ABASE(nxt) : cA; const char* nB = has_next ? (const char*)g.Bt + g.boff(nxt) : cB;
        if (has_next) PG8_AOFF(nxt, nvA0, nvA1); else { nvA0[0] = vA0[0]; nvA0[1] = vA0[1]; nvA1[0] = vA1[0]; nvA1[1] = vA1[1]; }
        for (int t = 0; t < nt; t += 2) {
            const bool last = (t == nt - 2);
            const char* a1 = cA + (size_t)(t + 1) * kstep;
            const char* a2 = last ? nA : cA + (size_t)(t + 2) * kstep; const char* b2 = last ? nB : cB + (size_t)(t + 2) * kstep;
            const char* a3 = a2 + kstep; const char* b3 = b2 + kstep;
            unsigned sA0[2], sA1[2]; sA0[0] = last ? nvA0[0] : vA0[0]; sA0[1] = last ? nvA0[1] : vA0[1]; sA1[0] = last ? nvA1[0] : vA1[0]; sA1[1] = last ? nvA1[1] : vA1[1];
            if (last && has_next) S.a_ready(nxt);
            if constexpr (SP2) {
            PG8_LDB(B0, 0, 0); PG8_LDB(B1, 0, 1); PG8_SCHED; PG8_LDA(At, 0, 0); PG8_STAGE(PG8_SA(1, 1), a1, vA1);
            PG8_WAIT_V(8); PG8_WAIT_L(0); PG8_BAR; PG8_MMA(0, 0, At, B0); PG8_MMA(0, 1, At, B1); PG8_BAR; PG8_SCHED;
            PG8_LDA(At, 0, 1); PG8_STAGE(PG8_SB(0, 0), b2, voffB); PG8_STAGE(PG8_SB(0, 1), b2 + hstep, voffB); PG8_STAGE(PG8_SA(0, 0), a2, sA0);
            PG8_WAIT_V(8); PG8_WAIT_L(0); PG8_BAR; PG8_MMA(1, 0, At, B0); PG8_MMA(1, 1, At, B1); PG8_BAR; PG8_SCHED;
            PG8_LDB(B0, 1, 0); PG8_LDB(B1, 1, 1); PG8_SCHED; PG8_LDA(At, 1, 0); PG8_STAGE(PG8_SA(0, 1), a2, sA1);
            PG8_WAIT_V(8); PG8_WAIT_L(0); PG8_BAR; PG8_MMA(0, 0, At, B0); PG8_MMA(0, 1, At, B1); PG8_BAR; PG8_SCHED;
            PG8_LDA(At, 1, 1); PG8_STAGE(PG8_SB(1, 0), b3, voffB); PG8_STAGE(PG8_SB(1, 1), b3 + hstep, voffB); PG8_STAGE(PG8_SA(1, 0), a3, sA0);
            PG8_WAIT_V(8); PG8_WAIT_L(0); PG8_BAR; PG8_MMA(1, 0, At, B0); PG8_MMA(1, 1, At, B1); PG8_BAR; PG8_SCHED;
            } else {
            PG8_LDB(B0, 0, 0); PG8_SCHED; PG8_LDA(At, 0, 0); PG8_STAGE(PG8_SA(1, 1), a1, vA1);
            PG8_WAIT_L(8); PG8_BAR; PG8_WAIT_L(0); PG8_MMA(0, 0, At, B0); PG8_BAR; PG8_SCHED;
            PG8_LDB(B1, 0, 1); PG8_STAGE(PG8_SB(0, 0), b2, voffB);
            PG8_BAR; PG8_WAIT_L(0); PG8_MMA(0, 1, At, B1); PG8_BAR;
            PG8_LDA(At, 0, 1); PG8_STAGE(PG8_SA(0, 0), a2, sA0);
            PG8_BAR; PG8_WAIT_L(0); PG8_MMA(1, 0, At, B0); PG8_BAR; PG8_SCHED;
            PG8_STAGE(PG8_SB(0, 1), b2 + hstep, voffB);
            PG8_WAIT_V(6); PG8_BAR; PG8_MMA(1, 1, At, B1); PG8_BAR;
            PG8_LDB(B0, 1, 0); PG8_SCHED; PG8_LDA(At, 1, 0); PG8_STAGE(PG8_SA(0, 1), a2, sA1);
            PG8_WAIT_L(8); PG8_BAR; PG8_WAIT_L(0); PG8_MMA(0, 0, At, B0); PG8_BAR; PG8_SCHED;
            PG8_LDB(B1, 1, 1); PG8_STAGE(PG8_SB(1, 0), b3, voffB);
            PG8_BAR; PG8_WAIT_L(0); PG8_MMA(0, 1, At, B1); PG8_BAR;
            PG8_LDA(At, 1, 1); PG8_STAGE(PG8_SA(1, 0), a3, sA0);
            PG8_BAR; PG8_WAIT_L(0); PG8_MMA(1, 0, At, B0); PG8_BAR; PG8_SCHED;
            PG8_STAGE(PG8_SB(1, 1), b3 + hstep, voffB);
            PG8_WAIT_V(6); PG8_BAR; PG8_MMA(1, 1, At, B1); PG8_BAR;
            }
        }
        if constexpr (ALIGN_EPI) { if (wr == 0) PG8_BAR; }
        if constexpr (!Epi::AFTER_DRAIN) { E(acc, cur, wr, wc, fr, fq); S.done(cur); }
        if (!has_next) break;
#pragma unroll
        for (int a = 0; a < 2; ++a)
#pragma unroll
            for (int b = 0; b < 2; ++b)
#pragma unroll
                for (int m = 0; m < 4; ++m)
#pragma unroll
                    for (int n = 0; n < 2; ++n) acc[a][b][m][n] = (f32x4){0.f, 0.f, 0.f, 0.f};
        cur = nxt; cA = nA; cB = nB; ++ui; vA0[0] = nvA0[0]; vA0[1] = nvA0[1]; vA1[0] = nvA1[0]; vA1[1] = nvA1[1];
        if constexpr (ALIGN_EPI) { if (wr == 1) PG8_BAR; }
    }
    PG8_WAIT_V(0);
    if constexpr (!ALIGN_EPI) { if (wr == 0) PG8_BAR; }
    PG8_BAR;
    if constexpr (Epi::AFTER_DRAIN) { E.fused(acc, cur, wr, wc, fr, fq, lds, wid, lane); S.done(cur); }
#undef PG8_SA
#undef PG8_SB
#undef PG8_STAGE
#undef PG8_AOFF
#undef PG8_ABASE
#undef PG8_LDA
#undef PG8_LDB
#undef PG8_MMA
#undef PG8_WAIT_V
#undef PG8_WAIT_L
#undef PG8_BAR
#undef PG8_SCHED
}
}

using pg8::u32x4; using pg8::Unit;
typedef unsigned u32x2 __attribute__((ext_vector_type(2)));
struct EpiInProj {
    static constexpr bool PERM = true, AFTER_DRAIN = false;
    bf16_t *QG, *Kb, *Vb, *GQKV; const float* rope;
    __device__ __forceinline__ void operator()(const f32x4 (&acc)[2][2][4][2], const Unit& u, int wr, int wc, int fr, int fq) const {
        const int b = u.pm / 33; const bool isctx = (u.pm % 33) == 0; const int pn = u.pn;
        bf16_t* base; int ld, rowoff = 0, colt; bool do_rope = false; float sc = 1.f;
        if (pn < 2) { if (isctx) return; base = QG; ld = 1024; rowoff = 256 * (b + 1); colt = pn * 256; do_rope = true; sc = 0.125f * 1.4426950408889634f; }
        else if (pn < 4) { base = Kb; ld = 512; colt = (pn - 2) * 256; do_rope = !isctx; }
        else if (pn < 6) { base = Vb; ld = 512; colt = (pn - 4) * 256; }
        else if (pn < 12) { base = GQKV; ld = 1536; colt = (pn - 6) * 256; }
        else { if (isctx) return; base = QG; ld = 1024; rowoff = 256 * (b + 1); colt = 512 + (pn - 12) * 256; }
        const int col0 = colt + wc * 32 + 8 * fq;
        const float sgn = fq < 2 ? -1.f : 1.f;
#pragma unroll
        for (int ai = 0; ai < 2; ++ai)
#pragma unroll
            for (int m = 0; m < 4; ++m) {
                const int r = u.pm * 256 + ai * 128 + wr * 64 + m * 16 + fr;
                bf16_t* rowp = base + (size_t)(r - rowoff) * ld + col0;
                if (do_rope) {
                    const int tt = r - b * LT - LC; const int pos = (wc & 1) ? (tt & 63) : (tt >> 6);
                    const float4* tp = (const float4*)(rope + (pos * 16 + 8 * (fq & 1)) * 2);
                    const float4 t0 = tp[0], t1 = tp[1], t2 = tp[2], t3 = tp[3];
                    const float cs[8] = {t0.x, t0.z, t1.x, t1.z, t2.x, t2.z, t3.x, t3.z}, sn[8] = {t0.y, t0.w, t1.y, t1.w, t2.y, t2.w, t3.y, t3.w};
#pragma unroll
                    for (int bj = 0; bj < 2; ++bj) {
                        const f32x4 v0 = acc[ai][bj][m][0], v1 = acc[ai][bj][m][1];
                        const float xv[8] = {v0[0], v0[1], v0[2], v0[3], v1[0], v1[1], v1[2], v1[3]}; float y[8];
#pragma unroll
                        for (int i = 0; i < 8; ++i) { auto sw_ = __builtin_amdgcn_permlane32_swap(__float_as_uint(xv[i]), __float_as_uint(xv[i]), false, false);
                            const float o = __uint_as_float(fq < 2 ? sw_[1] : sw_[0]); y[i] = (xv[i] * cs[i] + sgn * o * sn[i]) * sc; }
                        u32x4 w; w.x = pg8::cvt_pk_bf16(y[0], y[1]); w.y = pg8::cvt_pk_bf16(y[2], y[3]); w.z = pg8::cvt_pk_bf16(y[4], y[5]); w.w = pg8::cvt_pk_bf16(y[6], y[7]);
                        *(u32x4*)(rowp + bj * 128) = w;
                    }
                } else {
#pragma unroll
                    for (int bj = 0; bj < 2; ++bj) {
                        const f32x4 v0 = acc[ai][bj][m][0], v1 = acc[ai][bj][m][1];
                        u32x4 w; w.x = pg8::cvt_pk_bf16(v0[0], v0[1]); w.y = pg8::cvt_pk_bf16(v0[2], v0[3]); w.z = pg8::cvt_pk_bf16(v1[0], v1[1]); w.w = pg8::cvt_pk_bf16(v1[2], v1[3]);
                        *(u32x4*)(rowp + bj * 128) = w;
                    }
                }
            }
    }
};
struct EpiOutProj {
    static constexpr bool PERM = false, AFTER_DRAIN = false;
    const float* x; const float* mod; float* xn;
    __device__ __forceinline__ void operator()(const f32x4 (&acc)[2][2][4][2], const Unit& u, int wr, int wc, int fr, int fq) const {
        const int b = u.pm / 32; const float* gt1 = mod + b * 6144 + 2048;
        const int col0 = u.pn * 256 + wc * 32 + 4 * fq;
#pragma unroll
        for (int ai = 0; ai < 2; ++ai)
#pragma unroll
            for (int m = 0; m < 4; ++m) {
                const size_t off = (size_t)(u.pm * 256 + ai * 128 + wr * 64 + m * 16 + fr) * D + col0;
#pragma unroll
                for (int bj = 0; bj < 2; ++bj)
#pragma unroll
                    for (int n = 0; n < 2; ++n) {
                        const int co = bj * 128 + n * 16;
                        const f32x4 xv = *(const f32x4*)(x + off + co), gv = *(const f32x4*)(gt1 + col0 + co);
                        *(f32x4*)(xn + off + co) = xv + gv * acc[ai][bj][m][n];
                    }
            }
    }
};
struct EpiMoeUp {
    static constexpr bool PERM = true, AFTER_DRAIN = false;
    bf16_t* hid;
    __device__ __forceinline__ void operator()(const f32x4 (&acc)[2][2][4][2], const Unit& u, int wr, int wc, int fr, int fq) const {
        const int col0 = u.pn * 128 + wc * 32 + 8 * fq;
#pragma unroll
        for (int ai = 0; ai < 2; ++ai)
#pragma unroll
            for (int m = 0; m < 4; ++m) {
                bf16_t* rowp = hid + (size_t)(u.pm * 256 + ai * 128 + wr * 64 + m * 16 + fr) * 1024 + col0;
                float y[8];
#pragma unroll
                for (int n = 0; n < 2; ++n)
#pragma unroll
                    for (int i = 0; i < 4; ++i) y[n * 4 + i] = siluf(acc[ai][0][m][n][i]) * acc[ai][1][m][n][i];
                u32x4 w; w.x = pg8::cvt_pk_bf16(y[0], y[1]); w.y = pg8::cvt_pk_bf16(y[2], y[3]); w.z = pg8::cvt_pk_bf16(y[4], y[5]); w.w = pg8::cvt_pk_bf16(y[6], y[7]);
                *(u32x4*)rowp = w;
            }
    }
};
struct EpiMoeDown {
    static constexpr bool PERM = true, AFTER_DRAIN = false;
    bf16_t* ye; const float* gatel;
    __device__ __forceinline__ void operator()(const f32x4 (&acc)[2][2][4][2], const Unit& u, int wr, int wc, int fr, int fq) const {
        const int col0 = u.pn * 256 + wc * 32 + 8 * fq;
#pragma unroll
        for (int ai = 0; ai < 2; ++ai)
#pragma unroll
            for (int m = 0; m < 4; ++m) {
                const int r = u.pm * 256 + ai * 128 + wr * 64 + m * 16 + fr; const float gv = gatel[r];
                bf16_t* rowp = ye + (size_t)r * 1024 + col0;
#pragma unroll
                for (int bj = 0; bj < 2; ++bj) {
                    const f32x4 v0 = acc[ai][bj][m][0] * gv, v1 = acc[ai][bj][m][1] * gv;
                    u32x4 w; w.x = pg8::cvt_pk_bf16(v0[0], v0[1]); w.y = pg8::cvt_pk_bf16(v0[2], v0[3]); w.z = pg8::cvt_pk_bf16(v1[0], v1[1]); w.w = pg8::cvt_pk_bf16(v1[2], v1[3]);
                    *(u32x4*)(rowp + bj * 128) = w;
                }
            }
    }
};

__device__ __forceinline__ unsigned pk2(float lo, float hi) { return (unsigned)f2bf(lo) | ((unsigned)f2bf(hi) << 16); }
__device__ __forceinline__ void transpose_item(const float* W, int ldw, int k0, int n0, bf16_t* WT, int K, int dst_row0, LAS float* scr, int lane) {
    {
        const int kq = lane >> 3, n4 = (lane & 7) * 4;
        f32x4 wv[8];
#pragma unroll
        for (int i = 0; i < 8; ++i) wv[i] = *(const f32x4*)(W + (size_t)(k0 + kq + 8 * i) * ldw + n0 + n4);
#pragma unroll
        for (int i = 0; i < 8; ++i) { LAS float* sp = scr + (kq + 8 * i) * 33 + n4; sp[0] = wv[i][0]; sp[1] = wv[i][1]; sp[2] = wv[i][2]; sp[3] = wv[i][3]; }
    }
    asm volatile("s_waitcnt lgkmcnt(0)" ::: "memory");
    const int c = lane & 7;
#pragma unroll
    for (int j = 0; j < 4; ++j) { const int n = (lane >> 3) + 8 * j; const LAS float* s = scr + (8 * c) * 33 + n;
        uint4 o; o.x = pk2(s[0 * 33], s[1 * 33]); o.y = pk2(s[2 * 33], s[3 * 33]); o.z = pk2(s[4 * 33], s[5 * 33]); o.w = pk2(s[6 * 33], s[7 * 33]);
        *(uint4*)(WT + (size_t)(dst_row0 + n) * K + k0 + 8 * c) = o; }
    asm volatile("s_waitcnt lgkmcnt(0)" ::: "memory");
}
__device__ __forceinline__ void ph_convert_small(ArgsRef a, unsigned char* lds_raw) {
    const int tix_ = tid_fresh();
    const int lane = tix_ & 63, wave = tix_ >> 6;
    LAS float* scr = (LAS float*)((LAS unsigned char*)lds_raw + wave * 16384);
    const int gw = blockIdx.x * 8 + wave, NGW = gridDim.x * 8;
    bf16_t* WinT = (bf16_t*)(a.ws + WS_WIN_T);
    constexpr int I_IN = 16 * 112;
    for (int it = gw; it < I_IN; it += NGW) { const int kb = it / 112, nb = it % 112; transpose_item(a.w_in, INC, 64 * kb, 32 * nb, WinT, 1024, 32 * nb, scr, lane); }
    float* rope = (float*)(a.ws + WS_ROPE);
    for (int i = blockIdx.x * NT + tix_; i < 128 * 16; i += gridDim.x * NT) {
        const int pos = i >> 4, j = i & 15;
        const float ang = (float)pos * powf(10000.f, -(float)(2 * j) / 32.f);
        rope[2 * i] = cosf(ang); rope[2 * i + 1] = sinf(ang);
    }
}
__device__ __forceinline__ void convert_moe_chunk(ArgsRef a, unsigned char* lds_raw, int c, int tix) {
    const int lane = tix & 63, wave = tix >> 6;
    LAS float* scr = (LAS float*)((LAS unsigned char*)lds_raw + wave * 16384);
    bf16_t* Wgu = (bf16_t*)(a.ws + WS_WGU); bf16_t* Wd = (bf16_t*)(a.ws + WS_WD);
    const int it = c * 8 + wave;
    if (c >= 3072) { const int r = it - 3072 * 8; const int kb = r / 32, nb = r % 32; transpose_item(a.w_out, 1024, 64 * kb, 32 * nb, (bf16_t*)(a.ws + WS_WOUT_T), 1024, 32 * nb, scr, lane); return; }
    const int nb = it & 31, kb = (it >> 5) & 15, e = (it >> 9) & 15, mat = it >> 13;
    const int n0 = 32 * nb, k0 = 64 * kb;
    if (mat < 2) transpose_item((mat == 0 ? a.w_gate : a.w_up) + (size_t)e * 1024 * 1024, 1024, k0, n0, Wgu + (size_t)e * 2048 * 1024, 1024, 256 * (n0 >> 7) + mat * 128 + (n0 & 127), scr, lane);
    else transpose_item(a.w_down + (size_t)e * 1024 * 1024, 1024, k0, n0, Wd + (size_t)e * 1024 * 1024, 1024, n0, scr, lane);
}
__device__ __forceinline__ void prep_done_wait(ArgsRef a) {
    if (threadIdx.x == 0) {
        unsigned* p = (unsigned*)(a.ws + WS_CTL) + 12288 + 192; unsigned sp = 0;
        while (__hip_atomic_load(p, __ATOMIC_RELAXED, __HIP_MEMORY_SCOPE_AGENT) < gridDim.x && ++sp < (1u << 22)) __builtin_amdgcn_s_sleep(2);
        __builtin_amdgcn_fence(__ATOMIC_ACQUIRE, "agent");
        asm volatile("s_waitcnt vmcnt(0)" ::: "memory");
    }
    __syncthreads();
}
namespace att {
using bf16x8 = __attribute__((ext_vector_type(8))) short;
using s16x4 = __attribute__((ext_vector_type(4))) short;
using f32x16 = __attribute__((ext_vector_type(16))) float;
typedef short v4i16_t __attribute__((ext_vector_type(4)));
constexpr int KV = 64, NTILE = LT / KV, SLOTB = 32768, NSLOT = 3;
constexpr int OFF_WSF = 4 * SLOTB;
constexpr int OFF_UW = 160 * 1024 - 256 + 128;
__device__ __forceinline__ int crow(int r, int hi) { return (r & 3) + 8 * (r >> 2) + 4 * hi; }
__device__ __forceinline__ void glds16(const void* gsrc, unsigned lds_dst) { unsigned keep;
    asm volatile("s_mov_b32 %0, m0\n\ts_mov_b32 m0, %2\n\ts_nop 0\n\tglobal_load_lds_dwordx4 %1, off\n\ts_mov_b32 m0, %0" : "=&s"(keep) : "v"(gsrc), "s"(lds_dst) : "memory"); }
__device__ __forceinline__ void glds16s(const void* sbase, unsigned voff, unsigned lds_dst) { unsigned keep;
    asm volatile("s_mov_b32 %0, m0\n\ts_mov_b32 m0, %3\n\ts_nop 0\n\tglobal_load_lds_dwordx4 %2, %1\n\ts_mov_b32 m0, %0" : "=&s"(keep) : "s"(sbase), "v"(voff), "s"(lds_dst) : "memory"); }
__device__ __forceinline__ s16x4 vtr(const LAS unsigned char* p) { return __builtin_bit_cast(s16x4, __builtin_amdgcn_ds_read_tr16_b64_v4i16((LAS v4i16_t*)p)); }
__device__ __forceinline__ unsigned cvtpk(float lo, float hi) { return cvt2bf(lo, hi); }
#define ATT_BAR_V(N) asm volatile("s_waitcnt vmcnt(" #N ") lgkmcnt(0)\n\ts_barrier" ::: "memory")
#define ATT_BAR() asm volatile("s_waitcnt lgkmcnt(0)\n\ts_barrier" ::: "memory")

constexpr int KSPLIT = 2, NTS = NTILE / KSPLIT;
#define SBAR() __builtin_amdgcn_sched_barrier(0)
__device__ __forceinline__ void attn_unit(ArgsRef a, unsigned char* shm, int b, int h, int qb, int ks, bool first) {
    const int tid = tid_fresh(), lane = tid & 63, r32 = lane & 31, hi = lane >> 5;
    const int wid = __builtin_amdgcn_readfirstlane(tid >> 6);
    const int map = wid >> 2, qs = wid & 3;
    const bf16_t* Q = (const bf16_t*)(a.ws + WS_QG); const bf16_t* Kb = (const bf16_t*)(a.ws + WS_K); const bf16_t* Vb = (const bf16_t*)(a.ws + WS_V);
    const size_t m0 = (size_t)b * L + qb * 128 + qs * 32;
    const bf16_t* Kh = Kb + ((size_t)b * LT + (size_t)ks * NTS * KV) * 512 + h * 128;
    const bf16_t* Vh = Vb + ((size_t)b * LT + (size_t)ks * NTS * KV) * 512 + h * 128;
    const unsigned lds0 = (unsigned)(uintptr_t)shm;
    const LAS unsigned char* shm3 = (const LAS unsigned char*)shm;
    LAS float* wsf = (LAS float*)(shm3 + OFF_WSF) + wid * 64;
    bf16x8 qr[4];
#pragma unroll
    for (int d0 = 0; d0 < 4; ++d0) qr[d0] = *(const bf16x8*)(Q + (m0 + r32) * 1024 + h * 128 + map * 64 + 16 * d0 + 8 * hi);
    const int drow0 = 8 * wid + (lane >> 4), drow1 = drow0 + 4, dc = lane & 15;
    const unsigned ko0 = (unsigned)(drow0 * 1024 + (dc ^ (drow0 & 15)) * 16), ko1 = (unsigned)(drow1 * 1024 + (dc ^ (drow1 & 15)) * 16);
    const unsigned vo0 = (unsigned)(drow0 * 1024 + ((((dc >> 2) ^ (drow0 & 3)) << 2) | (dc & 3)) * 16), vo1 = (unsigned)(drow1 * 1024 + ((((dc >> 2) ^ (drow1 & 3)) << 2) | (dc & 3)) * 16);
    const unsigned kdst = lds0 + (2 * wid) * 1024, vdst = lds0 + 16384 + (2 * wid) * 1024;
#define A2_DMA1(piece, t, slot) do { const unsigned char* kt_ = (const unsigned char*)Kh + (size_t)(t) * KV * 1024; const unsigned char* vt_ = (const unsigned char*)Vh + (size_t)(t) * KV * 1024; const unsigned so_ = (unsigned)(slot) * SLOTB; \
        if ((piece) == 0) glds16s(kt_, ko0, (unsigned)__builtin_amdgcn_readfirstlane(kdst + so_)); else if ((piece) == 1) glds16s(kt_, ko1, (unsigned)__builtin_amdgcn_readfirstlane(kdst + so_ + 1024)); \
        else if ((piece) == 2) glds16s(vt_, vo0, (unsigned)__builtin_amdgcn_readfirstlane(vdst + so_)); else glds16s(vt_, vo1, (unsigned)__builtin_amdgcn_readfirstlane(vdst + so_ + 1024)); } while (0)
#define A2_DMA(t, slot) do { A2_DMA1(0, t, slot); A2_DMA1(1, t, slot); A2_DMA1(2, t, slot); A2_DMA1(3, t, slot); } while (0)
    A2_DMA(0, 0); A2_DMA(1, 1);
    __builtin_amdgcn_s_waitcnt(0);
    const int q4 = (lane & 15) >> 2;
    int kof[4], vof[4];
#pragma unroll
    for (int d0 = 0; d0 < 4; ++d0) { kof[d0] = r32 * 256 + (((8 * map + 2 * d0 + hi) ^ (r32 & 15)) << 4);
                                     vof[d0] = 16384 + (4 * hi + q4) * 256 + ((lane >> 4) & 1) * 32 + (lane & 3) * 8 + ((d0 ^ q4) << 6); }
    f32x16 o[4];
#pragma unroll
    for (int d0 = 0; d0 < 4; ++d0)
#pragma unroll
        for (int r = 0; r < 16; ++r) o[d0][r] = 0.f;
    float mref = 0.f, lsum = 0.f;
    f32x16 negm;
#pragma unroll
    for (int r = 0; r < 16; ++r) negm[r] = 0.f;
    f32x16 pA0, pA1, pB0, pB1;
    bf16x8 pw[4];
#define A2_ROWMAX(C0, C1, rm) do { float rm2_; rm = __builtin_fmaxf(__builtin_fmaxf(C0[0], C1[0]), C0[1]); rm2_ = __builtin_fmaxf(__builtin_fmaxf(C1[1], C0[2]), C1[2]); \
        _Pragma("unroll") for (int r = 3; r < 15; r += 2) { rm = __builtin_fmaxf(__builtin_fmaxf(rm, C0[r]), C1[r]); rm2_ = __builtin_fmaxf(__builtin_fmaxf(rm2_, C0[r + 1]), C1[r + 1]); } \
        rm = __builtin_fmaxf(__builtin_fmaxf(rm, C0[15]), C1[15]); rm = __builtin_fmaxf(rm, rm2_); \
        { auto sw_ = __builtin_amdgcn_permlane32_swap(__float_as_uint(rm), __float_as_uint(rm), false, false); rm = __builtin_fmaxf(__uint_as_float(sw_[0]), __uint_as_float(sw_[1])); } } while (0)
#define A2_RESCALE_O(alpha) do { if (hi == 0) wsf[r32] = (alpha); \
        _Pragma("unroll") for (int r = 0; r < 16; ++r) { const float f = wsf[crow(r, hi)]; _Pragma("unroll") for (int d0 = 0; d0 < 4; ++d0) o[d0][r] *= f; } } while (0)
#define A2_VF(g) (bf16x8){vlo[(g) % 3][0], vlo[(g) % 3][1], vlo[(g) % 3][2], vlo[(g) % 3][3], vhi[(g) % 3][0], vhi[(g) % 3][1], vhi[(g) % 3][2], vhi[(g) % 3][3]}
#define A2_VRD(g) do { vlo[(g) % 3] = vtr(vb + vof[(g) >> 2] + ((g) & 3) * 4096); vhi[(g) % 3] = vtr(vb + vof[(g) >> 2] + ((g) & 3) * 4096 + 2048); } while (0)
    ATT_BAR_V(0);
    A2_DMA(2, 2);
    {
        const LAS unsigned char* kb = shm3;
        pA0 = negm; pA1 = negm;
#pragma unroll
        for (int d0 = 0; d0 < 4; ++d0) { const bf16x8 k0 = *(const LAS bf16x8*)(kb + kof[d0]), k1 = *(const LAS bf16x8*)(kb + kof[d0] + 8192);
            pA0 = __builtin_amdgcn_mfma_f32_32x32x16_bf16(k0, qr[d0], pA0, 0, 0, 0); pA1 = __builtin_amdgcn_mfma_f32_32x32x16_bf16(k1, qr[d0], pA1, 0, 0, 0); }
        float rm; A2_ROWMAX(pA0, pA1, rm);
        if (__any(rm > 8.f)) { const float dl = fmaxf(rm, 0.f); mref += dl;
#pragma unroll
            for (int r = 0; r < 16; ++r) { pA0[r] -= dl; pA1[r] -= dl; negm[r] = -mref; } }
#pragma unroll
        for (int r = 0; r < 16; ++r) { pA0[r] = __builtin_amdgcn_exp2f(pA0[r]); pA1[r] = __builtin_amdgcn_exp2f(pA1[r]); }
    }
#define A2_STEP(C0, C1, P0, P1, t_, DO_DMA) do { \
        const LAS unsigned char* kb = shm3 + ((t_) & 3) * SLOTB; const LAS unsigned char* vb = shm3 + (((t_) - 1) & 3) * SLOTB; \
        bf16x8 kf[3];     \
        kf[0] = *(const LAS bf16x8*)(kb + kof[0]); kf[1] = *(const LAS bf16x8*)(kb + kof[0] + 8192); \
        s16x4 vlo[3], vhi[3]; \
        C0 = negm; C1 = negm; float sacc = 0.f; u32x4 w_[4]; SBAR(); \
        _Pragma("unroll") for (int i = 0; i < 8; ++i) { \
            if (i + 2 < 8) kf[(i + 2) % 3] = *(const LAS bf16x8*)(kb + kof[(i + 2) >> 1] + ((i + 2) & 1) * 8192); \
            if (i == 6) A2_VRD(0); if (i == 7) A2_VRD(1); \
            if (i & 1) C1 = __builtin_amdgcn_mfma_f32_32x32x16_bf16(kf[i % 3], qr[i >> 1], C1, 0, 0, 0); else C0 = __builtin_amdgcn_mfma_f32_32x32x16_bf16(kf[i % 3], qr[i >> 1], C0, 0, 0, 0); \
            const int e_ = 4 * (i & 3); \
            if (i < 4) { sacc += P0[e_]; sacc += P0[e_ + 1]; sacc += P0[e_ + 2]; sacc += P0[e_ + 3]; asm volatile("" : "+v"(sacc)); w_[i >> 1][(i & 1) * 2] = cvtpk(P0[e_], P0[e_ + 1]); w_[i >> 1][(i & 1) * 2 + 1] = cvtpk(P0[e_ + 2], P0[e_ + 3]); } \
            else       { sacc += P1[e_]; sacc += P1[e_ + 1]; sacc += P1[e_ + 2]; sacc += P1[e_ + 3]; asm volatile("" : "+v"(sacc)); w_[i >> 1][(i & 1) * 2] = cvtpk(P1[e_], P1[e_ + 1]); w_[i >> 1][(i & 1) * 2 + 1] = cvtpk(P1[e_ + 2], P1[e_ + 3]); } \
            asm volatile("" : "+v"(w_[i >> 1]));     \
            SBAR(); } \
        lsum += sacc; \
        _Pragma("unroll") for (int k_ = 0; k_ < 4; ++k_) pw[k_] = __builtin_bit_cast(bf16x8, w_[k_]); \
        float rm; A2_ROWMAX(C0, C1, rm); \
        const bool resc = __any(rm > 8.f); float alpha = 1.f; \
        if (resc) { const float dl = fmaxf(rm, 0.f); mref += dl; alpha = __builtin_amdgcn_exp2f(-dl); \
            _Pragma("unroll") for (int r = 0; r < 16; ++r) { C0[r] -= dl; C1[r] -= dl; negm[r] = -mref; } } \
        SBAR(); \
        _Pragma("unroll") for (int g = 0; g < 16; ++g) { \
            if (g + 2 < 16) A2_VRD(g + 2); \
            o[g >> 2] = __builtin_amdgcn_mfma_f32_32x32x16_bf16(pw[g & 3], A2_VF(g), o[g >> 2], 0, 0, 0); \
            if (g < 8) { C0[2 * g] = __builtin_amdgcn_exp2f(C0[2 * g]); C0[2 * g + 1] = __builtin_amdgcn_exp2f(C0[2 * g + 1]); asm volatile("" : "+v"(C0)); } \
            else { C1[2 * (g - 8)] = __builtin_amdgcn_exp2f(C1[2 * (g - 8)]); C1[2 * (g - 8) + 1] = __builtin_amdgcn_exp2f(C1[2 * (g - 8) + 1]); asm volatile("" : "+v"(C1)); } \
            if (DO_DMA && (g & 3) == 3) A2_DMA1(g >> 2, (t_) + 2, ((t_) + 2) & 3); \
            SBAR(); } \
        if (resc) { lsum *= alpha; A2_RESCALE_O(alpha); } } while (0)
    int t = 1;
    for (; t + 3 < NTS; t += 2) {
        ATT_BAR_V(4); A2_STEP(pB0, pB1, pA0, pA1, t, true);
        ATT_BAR_V(4); A2_STEP(pA0, pA1, pB0, pB1, t + 1, true);
    }
    ATT_BAR_V(4); A2_STEP(pB0, pB1, pA0, pA1, t, true); ++t;
    ATT_BAR_V(4); A2_STEP(pA0, pA1, pB0, pB1, t, false); ++t;
    ATT_BAR_V(0); A2_STEP(pB0, pB1, pA0, pA1, t, false);
    {
        float sacc = 0.f;
#pragma unroll
        for (int r = 0; r < 16; ++r) sacc += pB0[r] + pB1[r];
        lsum += sacc;
#pragma unroll
        for (int s = 0; s < 2; ++s) { u32x4 w0, w1;
            w0.x = cvtpk(pB0[8 * s], pB0[8 * s + 1]); w0.y = cvtpk(pB0[8 * s + 2], pB0[8 * s + 3]); w0.z = cvtpk(pB0[8 * s + 4], pB0[8 * s + 5]); w0.w = cvtpk(pB0[8 * s + 6], pB0[8 * s + 7]);
            w1.x = cvtpk(pB1[8 * s], pB1[8 * s + 1]); w1.y = cvtpk(pB1[8 * s + 2], pB1[8 * s + 3]); w1.z = cvtpk(pB1[8 * s + 4], pB1[8 * s + 5]); w1.w = cvtpk(pB1[8 * s + 6], pB1[8 * s + 7]);
            pw[s] = __builtin_bit_cast(bf16x8, w0); pw[2 + s] = __builtin_bit_cast(bf16x8, w1); }
        const LAS unsigned char* vb = shm3 + ((NTS - 1) & 3) * SLOTB;
#pragma unroll
        for (int d0 = 0; d0 < 4; ++d0)
#pragma unroll
            for (int k2 = 0; k2 < 4; ++k2) { const s16x4 lo = vtr(vb + vof[d0] + k2 * 4096), hv = vtr(vb + vof[d0] + k2 * 4096 + 2048);
                const bf16x8 vf = {lo[0], lo[1], lo[2], lo[3], hv[0], hv[1], hv[2], hv[3]};
                o[d0] = __builtin_amdgcn_mfma_f32_32x32x16_bf16(pw[k2], vf, o[d0], 0, 0, 0); }
    }
#undef A2_STEP
#undef A2_VRD
#undef A2_VF
#undef A2_ROWMAX
#undef A2_DMA
#undef A2_DMA1
    const float lt = lsum + __shfl_xor(lsum, 32);
    const float inv = 1.f / lt;
    ATT_BAR();
    if (hi == 0) wsf[r32] = inv;
#pragma unroll
    for (int r = 0; r < 16; ++r) { const float f = wsf[crow(r, hi)];
#pragma unroll
        for (int d0 = 0; d0 < 4; ++d0) o[d0][r] *= f; }
    if (first) prep_done_wait(a);
    const int piece = ks * 2 + map;
    bf16_t* PO = (bf16_t*)(a.ws + (piece == 0 ? WS_PO0 : piece == 1 ? WS_PO1 : piece == 2 ? WS_PO2 : WS_PO3));
    LAS bf16_t* stg = (LAS bf16_t*)shm3 + wid * 4096;
#pragma unroll
    for (int d0 = 0; d0 < 4; ++d0)
#pragma unroll
        for (int r = 0; r < 16; ++r) stg[crow(r, hi) * 128 + 32 * d0 + r32] = f2bf(o[d0][r]);
    asm volatile("s_waitcnt lgkmcnt(0)" ::: "memory");
#pragma unroll
    for (int i = 0; i < 8; ++i) { const int row = i * 4 + (lane >> 4), ch = lane & 15;
        const u32x4 v = *(const LAS u32x4*)(stg + row * 128 + ch * 8);
        *(u32x4*)(PO + (m0 + row) * 512 + h * 128 + ch * 8) = v; }
    if (hi == 0) { float2 ml; ml.x = mref; ml.y = lt; *(float2*)((float*)(a.ws + WS_ML) + (((size_t)piece * M + m0 + r32) * 4 + h) * 2) = ml; }
    ATT_BAR();
}
#undef SBAR
}
__device__ __forceinline__ void ph_attn(ArgsRef a, unsigned char* shm, int pass = 0) {
    const int tix_ = tid_fresh();
    unsigned* cnt = (unsigned*)(a.ws + WS_CTL) + 8192 + pass * 1024;
    volatile LAS int* uw = (volatile LAS int*)((LAS unsigned char*)shm + att::OFF_UW);
    bool first = true;
    for (;;) {
        if (tix_ == 0) {
            int u = -1; const int q = blockIdx.x & 7;
            for (int s = 0; s < 8; ++s) { const int k = (q + s) & 7; const unsigned v = __hip_atomic_fetch_add(cnt + k * 64, 1u, __ATOMIC_RELAXED, __HIP_MEMORY_SCOPE_AGENT); if (v < 128u) { u = k * 128 + (int)v; break; } }
            uw[0] = u;
        }
        __syncthreads();
        const int u = uw[0];
        __syncthreads();
        if (u < 0) break;
        att::attn_unit(a, shm, u >> 9, (u >> 7) & 3, u & 63, (u >> 6) & 1, first);
        first = false;
    }
    if (pass) return;
    unsigned* ctl = (unsigned*)(a.ws + WS_CTL);
    if (tix_ == 0) { unsigned sp = 0; while (__hip_atomic_load(ctl + 12288, __ATOMIC_RELAXED, __HIP_MEMORY_SCOPE_AGENT) < 16u && ++sp < (1u << 22)) __builtin_amdgcn_s_sleep(8); }
    __syncthreads();
    for (;;) {
        if (tix_ == 0) uw[0] = (int)__hip_atomic_fetch_add(ctl + 12288 + 64, 1u, __ATOMIC_RELAXED, __HIP_MEMORY_SCOPE_AGENT);
        __syncthreads();
        const int c = uw[0];
        __syncthreads();
        if (c >= 2048 + 64) break;
        convert_moe_chunk(a, shm, c < 2048 ? c : c + 1024, tix_);
    }
}
__device__ __forceinline__ void ph_fill_wdown(ArgsRef a, unsigned char* shm) {
    const int tix_ = tid_fresh();
    unsigned* ctl = (unsigned*)(a.ws + WS_CTL);
    volatile LAS int* uw = (volatile LAS int*)((LAS unsigned char*)shm + att::OFF_UW);
    for (;;) {
        if (tix_ == 0) uw[0] = (int)__hip_atomic_fetch_add(ctl + 12288 + 128, 1u, __ATOMIC_RELAXED, __HIP_MEMORY_SCOPE_AGENT);
        __syncthreads();
        const int c = uw[0];
        __syncthreads();
        if (c >= 1024) break;
        convert_moe_chunk(a, shm, 2048 + c, tix_);
    }
}

__device__ __forceinline__ int gdn_row(int d, int b, int cs, int i) {
    const bool isctx = cs < 4; const int n = isctx ? cs : cs - 4; const int len = isctx ? LC : L; const int base = b * LT + (isctx ? 0 : LC);
    const int p = n * 64 + i; return base + (d == 0 ? p : len - 1 - p);
}
namespace gdn {
using bf16x8 = __attribute__((ext_vector_type(8))) short;
using f32x16 = __attribute__((ext_vector_type(16))) float;
__device__ __forceinline__ int crow(int r, int hi) { return (r & 3) + 8 * (r >> 2) + 4 * hi; }
__device__ __forceinline__ int pch(int x) { return 2 * (x >> 4) + ((x >> 2) & 1); }
__device__ __forceinline__ int pj(int x) { return 4 * ((x >> 3) & 1) + (x & 3); }
__device__ __forceinline__ unsigned cvtpk(float lo, float hi) { return cvt2bf(lo, hi); }
__device__ __forceinline__ bf16x8 pack8(const f32x16& x, int s) {
    u32x4 w; w.x = cvtpk(x[8 * s], x[8 * s + 1]); w.y = cvtpk(x[8 * s + 2], x[8 * s + 3]); w.z = cvtpk(x[8 * s + 4], x[8 * s + 5]); w.w = cvtpk(x[8 * s + 6], x[8 * s + 7]);
    return __builtin_bit_cast(bf16x8, w);
}
#define GDN_MFMA(A, B, C) __builtin_amdgcn_mfma_f32_32x32x16_bf16((A), (B), (C), 0, 0, 0)
typedef short v4i16g __attribute__((ext_vector_type(4)));
using s16x4 = __attribute__((ext_vector_type(4))) short;
__device__ __forceinline__ s16x4 vtr(const LAS unsigned char* p) { return __builtin_bit_cast(s16x4, __builtin_amdgcn_ds_read_tr16_b64_v4i16((LAS v4i16g*)p)); }
__device__ __forceinline__ bf16x8 trfrag(const LAS unsigned char* img, int r0, int r1, int tile, int lane) {
    const int q = (lane & 15) >> 2, po = ((lane >> 4) & 1) * 32 + (lane & 3) * 8;
    const s16x4 lo = vtr(img + (r0 + q) * 256 + ((tile ^ q) << 6) + po), hv = vtr(img + (r1 + q) * 256 + ((tile ^ q) << 6) + po);
    return (bf16x8){lo[0], lo[1], lo[2], lo[3], hv[0], hv[1], hv[2], hv[3]};
}
constexpr int AQK_GL_OFF = 4096;
constexpr int P_KNA = 0, P_QNA = 16384, P_KBT = 32768, P_VBT = 49152, P_QDS = 65536, P_KDTS = 81920, P_AF = 98304, P_TF = 115200, P_TIMG = 132096, P_GS = 140288, P_MT = 141312, P_MT2 = 143488;
__device__ __forceinline__ void prep(ArgsRef a, unsigned char* shm) {
    LAS unsigned char* s3 = (LAS unsigned char*)shm;
    LAS bf16_t* KnA = (LAS bf16_t*)(s3 + P_KNA); LAS bf16_t* QnA = (LAS bf16_t*)(s3 + P_QNA); LAS bf16_t* KBt = (LAS bf16_t*)(s3 + P_KBT); LAS bf16_t* VBt = (LAS bf16_t*)(s3 + P_VBT);
    LAS bf16_t* QDs = (LAS bf16_t*)(s3 + P_QDS); LAS bf16_t* KDTs = (LAS bf16_t*)(s3 + P_KDTS);
    LAS float* Af = (LAS float*)(s3 + P_AF); LAS float* Tf = (LAS float*)(s3 + P_TF); LAS bf16_t* TImg = (LAS bf16_t*)(s3 + P_TIMG);
    LAS float* gc = (LAS float*)(s3 + P_GS); LAS float* be = gc + 64; LAS float* eg = gc + 128; LAS float* ekd = gc + 192;
    LAS float* Mt = (LAS float*)(s3 + P_MT); LAS float* Mt2 = (LAS float*)(s3 + P_MT2);
    const bf16_t* GQKVr = (const bf16_t*)(a.ws + WS_GQKV);
    unsigned char* WN = a.ws + WS_WN; unsigned char* QD = a.ws + WS_QD; unsigned char* AQK = a.ws + WS_AQK; unsigned char* UB = a.ws + WS_UB; unsigned char* KDT = a.ws + WS_KDT; float* GL = (float*)(a.ws + WS_GL);
    const int t0 = tid_fresh();
    const int w = __builtin_amdgcn_readfirstlane(t0 >> 6);
    u32x4 nxm[6], nx0[6], nxp[6]; float ngx = 0.f, ngb = 0.f;
#define PREP_FETCH(ci_) do { const int cs_ = (ci_) % NCH, h_ = ((ci_) / NCH) & 3, b_ = ((ci_) / (NCH * 4)) % NB, d_ = (ci_) / (NCH * 4 * NB); \
        _Pragma("unroll") for (int kk = 0; kk < 6; ++kk) { const int p = t0 + NT * kk, mat = kk >> 1, row = (p >> 4) & 63, ch = p & 15; \
            const int r = gdn_row(d_, b_, cs_, row), j = r % LT; \
            const bool has_prev = !(j == 0 || j == LC), has_next = !(j == LC - 1 || j == LT - 1); \
            const bf16_t* gp = GQKVr + (size_t)r * 1536 + mat * 512 + h_ * 128 + ch * 8; \
            const u32x4 z = {0u, 0u, 0u, 0u}; \
            nx0[kk] = *(const u32x4*)gp; nxm[kk] = has_prev ? *(const u32x4*)(gp - 1536) : z; nxp[kk] = has_next ? *(const u32x4*)(gp + 1536) : z; } \
        if (t0 < 64) { const float* abr = (const float*)(a.ws + WS_AB) + (size_t)gdn_row(d_, b_, cs_, t0) * 16 + d_ * 4 + h_; ngx = abr[0]; ngb = abr[8]; } } while (0)
#define PREP_CI(j_) ((j_) < 2048 ? ((j_) >> 7) * NCH + 4 + ((j_) & 127) : (((j_) - 2048) >> 2) * NCH + (((j_) - 2048) & 3))
    if ((int)blockIdx.x < NCI) PREP_FETCH(PREP_CI((int)blockIdx.x));
    for (int cj = blockIdx.x; cj < NCI; cj += gridDim.x) {
        const int ci = PREP_CI(cj);
        const int cs = ci % NCH, h = (ci / NCH) & 3, b = (ci / (NCH * 4)) % NB, d = ci / (NCH * 4 * NB);
        const bool lat = cs >= 4;
        int t = t0; asm volatile("" : "+v"(t));
        const int lane = t & 63, r32 = lane & 31, hi = lane >> 5;
        u32x4 rawm[6], raw0[6], rawp[6];
#pragma unroll
        for (int kk = 0; kk < 6; ++kk) { rawm[kk] = nxm[kk]; raw0[kk] = nx0[kk]; rawp[kk] = nxp[kk]; }
        const float gxa = ngx, gxb = ngb;
        __syncthreads();
        if (cj + (int)gridDim.x < NCI) PREP_FETCH(PREP_CI(cj + (int)gridDim.x));
        if (t < 64) {
            const float xa = gxa + a.dt_bias[d * 4 + h];
            float g = -expf(a.a_log[d * 4 + h]) * (fmaxf(xa, 0.f) + log1pf(expf(-fabsf(xa))));
            const float bt = 1.f / (1.f + expf(-gxb));
#pragma unroll
            for (int o = 1; o < 64; o <<= 1) { const float v = __shfl_up(g, o); if (lane >= o) g += v; }
            const float gl = __shfl(g, 63);
            gc[t] = g; be[t] = bt; eg[t] = __expf(g); ekd[t] = __expf(gl - g);
            if (t == 63) *(float*)(AQK + (size_t)ci * 8192 + AQK_GL_OFF) = __expf(g);
        }
        for (int i = t; i < 64 * 65; i += NT) Tf[i] = 0.f;
        __syncthreads();
        float cw[3][8];
#pragma unroll
        for (int kk = 0; kk < 6; ++kk) {
            const int p = t + NT * kk, mat = kk >> 1, row = (p >> 4) & 63, ch = p & 15;
            float v[8]; float ss = 0.f;
            if ((kk & 1) == 0) {
                const float* cwp = a.conv_w + mat * 512 + h * 128 + ch * 8;
#pragma unroll
                for (int tp = 0; tp < 3; ++tp) { const f32x4 c0v = *(const f32x4*)(cwp + tp * 1536), c1v = *(const f32x4*)(cwp + tp * 1536 + 4);
                    cw[tp][0] = c0v[0]; cw[tp][1] = c0v[1]; cw[tp][2] = c0v[2]; cw[tp][3] = c0v[3]; cw[tp][4] = c1v[0]; cw[tp][5] = c1v[1]; cw[tp][6] = c1v[2]; cw[tp][7] = c1v[3]; }
            }
#pragma unroll
            for (int e = 0; e < 8; ++e) {
                const unsigned wm = rawm[kk][e >> 1], w0 = raw0[kk][e >> 1], wp = rawp[kk][e >> 1];
                const float fm = (e & 1) ? __uint_as_float(wm & 0xffff0000u) : __uint_as_float(wm << 16);
                const float f0 = (e & 1) ? __uint_as_float(w0 & 0xffff0000u) : __uint_as_float(w0 << 16);
                const float fp = (e & 1) ? __uint_as_float(wp & 0xffff0000u) : __uint_as_float(wp << 16);
                v[e] = siluf(cw[0][e] * fm + cw[1][e] * f0 + cw[2][e] * fp); ss += v[e] * v[e]; }
            if (mat < 2) {
                ss += __shfl_xor(ss, 1); ss += __shfl_xor(ss, 2); ss += __shfl_xor(ss, 4); ss += __shfl_xor(ss, 8);
                const float sc = rsqrtf(ss + EPS) * (mat == 0 ? 0.08838834764831845f : 1.f);
#pragma unroll
                for (int e = 0; e < 8; ++e) v[e] *= sc;
            }
            u32x4 raw; raw.x = pk2(v[0], v[1]); raw.y = pk2(v[2], v[3]); raw.z = pk2(v[4], v[5]); raw.w = pk2(v[6], v[7]);
#pragma unroll
            for (int e = 0; e < 8; ++e) v[e] = (e & 1) ? __uint_as_float(raw[e >> 1] & 0xffff0000u) : __uint_as_float(raw[e >> 1] << 16);
            if (mat == 1) {
                *(LAS u32x4*)(KnA + (ch * 64 + row) * 8) = raw;
                const float s1 = be[row] * eg[row], s2 = ekd[row];
                const int pos = row * 128 + (((((ch >> 2) ^ (row & 3)) << 2) | (ch & 3)) * 8);
                u32x4 w1, w2; w1.x = pk2(v[0] * s1, v[1] * s1); w1.y = pk2(v[2] * s1, v[3] * s1); w1.z = pk2(v[4] * s1, v[5] * s1); w1.w = pk2(v[6] * s1, v[7] * s1);
                w2.x = pk2(v[0] * s2, v[1] * s2); w2.y = pk2(v[2] * s2, v[3] * s2); w2.z = pk2(v[4] * s2, v[5] * s2); w2.w = pk2(v[6] * s2, v[7] * s2);
                *(LAS u32x4*)(KBt + pos) = w1; *(LAS u32x4*)(KDTs + pos) = w2;
            } else if (mat == 0) {
                *(LAS u32x4*)(QnA + (ch * 64 + row) * 8) = raw;
                if (lat) {
                    const float s = eg[row];
                    u32x2 q0, q1; q0.x = pk2(v[0] * s, v[1] * s); q0.y = pk2(v[2] * s, v[3] * s); q1.x = pk2(v[4] * s, v[5] * s); q1.y = pk2(v[6] * s, v[7] * s);
                    const int cb = 2 * (ch >> 1), jo = 4 * (ch & 1);
                    *(LAS u32x2*)(QDs + ((cb + 0) * 64 + row) * 8 + jo) = q0;
                    *(LAS u32x2*)(QDs + ((cb + 1) * 64 + row) * 8 + jo) = q1;
                }
            } else {
                const float s = be[row];
                const int pos = row * 128 + (((((ch >> 2) ^ (row & 3)) << 2) | (ch & 3)) * 8);
                u32x4 w1; w1.x = pk2(v[0] * s, v[1] * s); w1.y = pk2(v[2] * s, v[3] * s); w1.z = pk2(v[4] * s, v[5] * s); w1.w = pk2(v[6] * s, v[7] * s);
                *(LAS u32x4*)(VBt + pos) = w1;
            }
        }
        __syncthreads();
        if (w < 3 || (w < 6 && lat)) {
            const int job = w < 3 ? w : w - 3; const int it = job == 0 ? 0 : 1, jt = job == 2 ? 1 : 0;
            f32x16 acc;
#pragma unroll
            for (int r = 0; r < 16; ++r) acc[r] = 0.f;
            if (w < 3) {
#pragma unroll
                for (int ks = 0; ks < 8; ++ks) {
                    const bf16x8 fa = *(const LAS bf16x8*)(KnA + ((2 * ks + hi) * 64 + 32 * it + r32) * 8), fb = *(const LAS bf16x8*)(KnA + ((2 * ks + hi) * 64 + 32 * jt + r32) * 8);
                    acc = GDN_MFMA(fa, fb, acc);
                }
                const int j = 32 * jt + r32; const float gj = gc[j];
#pragma unroll
                for (int r = 0; r < 16; ++r) { const int i = 32 * it + crow(r, hi); Af[i * 65 + j] = (j < i) ? be[i] * acc[r] * __expf(gc[i] - gj) : 0.f; }
            } else {
#pragma unroll
                for (int ks = 0; ks < 8; ++ks) {
                    const bf16x8 fa = *(const LAS bf16x8*)(KnA + ((2 * ks + hi) * 64 + 32 * jt + r32) * 8), fb = *(const LAS bf16x8*)(QnA + ((2 * ks + hi) * 64 + 32 * it + r32) * 8);
                    acc = GDN_MFMA(fa, fb, acc);
                }
                const int i = 32 * it + r32; const float gi = gc[i];
#pragma unroll
                for (int r = 0; r < 16; ++r) { const int j = 32 * jt + crow(r, hi); acc[r] = (j <= i) ? acc[r] * __expf(gi - gc[j]) : 0.f; }
#pragma unroll
                for (int s = 0; s < 2; ++s) { const bf16x8 pk = pack8(acc, s); *(bf16x8*)(AQK + (size_t)ci * 8192 + ((2 * (2 * jt + s) + hi) * 64 + i) * 16) = pk; }
            }
        }
        __syncthreads();
        if (t < 64) {
            const int blk = t >> 4, c = t & 15, o = 16 * blk; float x[16];
#pragma unroll
            for (int i = 0; i < 16; ++i) {
                float s = 0.f;
#pragma unroll
                for (int j = 0; j < i; ++j) s += Af[(o + i) * 65 + o + j] * x[j];
                x[i] = (i == c ? 1.f : 0.f) - s;
            }
#pragma unroll
            for (int i = 0; i < 16; ++i) Tf[(o + i) * 65 + o + c] = x[i];
        }
        __syncthreads();
        { const int pq = t >> 8, i = (t >> 4) & 15, c = t & 15, o = 32 * pq; float s = 0.f;
#pragma unroll
          for (int j = 0; j < 16; ++j) s += Af[(o + 16 + i) * 65 + o + j] * Tf[(o + j) * 65 + o + c];
          Mt[(pq * 16 + i) * 17 + c] = s; }
        __syncthreads();
        { const int pq = t >> 8, i = (t >> 4) & 15, c = t & 15, o = 32 * pq; float s = 0.f;
#pragma unroll
          for (int j = 0; j < 16; ++j) s += Tf[(o + 16 + i) * 65 + o + 16 + j] * Mt[(pq * 16 + j) * 17 + c];
          Tf[(o + 16 + i) * 65 + o + c] = -s; }
        __syncthreads();
#pragma unroll
        for (int k = 0; k < 2; ++k) { const int e = t + NT * k, i = e >> 5, c = e & 31; float s = 0.f;
#pragma unroll 8
            for (int j = 0; j < 32; ++j) s += Af[(32 + i) * 65 + j] * Tf[j * 65 + c];
            Mt2[i * 33 + c] = s; }
        __syncthreads();
#pragma unroll
        for (int k = 0; k < 2; ++k) { const int e = t + NT * k, i = e >> 5, c = e & 31; float s = 0.f;
#pragma unroll 8
            for (int j = 0; j < 32; ++j) s += Tf[(32 + i) * 65 + 32 + j] * Mt2[j * 33 + c];
            Tf[(32 + i) * 65 + c] = -s; }
        __syncthreads();
        { const int i = t >> 3, ch = t & 7; u32x4 o;
          o.x = pk2(Tf[i * 65 + 8 * ch], Tf[i * 65 + 8 * ch + 1]); o.y = pk2(Tf[i * 65 + 8 * ch + 2], Tf[i * 65 + 8 * ch + 3]);
          o.z = pk2(Tf[i * 65 + 8 * ch + 4], Tf[i * 65 + 8 * ch + 5]); o.w = pk2(Tf[i * 65 + 8 * ch + 6], Tf[i * 65 + 8 * ch + 7]);
          *(LAS u32x4*)(TImg + (ch * 64 + i) * 8) = o; }
        __syncthreads();
        {
            const int dkt = w >> 1, it = w & 1; const int nks = it == 0 ? 2 : 4;
            f32x16 acc;
#pragma unroll
            for (int r = 0; r < 16; ++r) acc[r] = 0.f;
#pragma unroll
            for (int ks = 0; ks < 4; ++ks) if (ks < nks) {
                const bf16x8 fa = trfrag((const LAS unsigned char*)KBt, 16 * ks + 8 * hi, 16 * ks + 8 * hi + 4, dkt, lane), fb = *(const LAS bf16x8*)(TImg + ((2 * ks + hi) * 64 + 32 * it + r32) * 8);
                acc = GDN_MFMA(fa, fb, acc);
            }
#pragma unroll
            for (int r = 0; r < 16; ++r) acc[r] = -acc[r];
            const int i = 32 * it + r32;
#pragma unroll
            for (int s = 0; s < 2; ++s) { const bf16x8 pk = pack8(acc, s); *(bf16x8*)(WN + (size_t)ci * 16384 + ((2 * (2 * dkt + s) + hi) * 64 + i) * 16) = pk; }
        }
        {
            const int it = w >> 2, dvt = w & 3; const int nks = it == 0 ? 2 : 4;
            f32x16 acc;
#pragma unroll
            for (int r = 0; r < 16; ++r) acc[r] = 0.f;
#pragma unroll
            for (int ks = 0; ks < 4; ++ks) if (ks < nks) {
                const bf16x8 fa = *(const LAS bf16x8*)(TImg + ((2 * ks + hi) * 64 + 32 * it + r32) * 8), fb = trfrag((const LAS unsigned char*)VBt, 16 * ks + 8 * hi, 16 * ks + 8 * hi + 4, dvt, lane);
                acc = GDN_MFMA(fa, fb, acc);
            }
            unsigned char* dst = UB + (size_t)ci * 16384 + ((it * 4 + dvt) * 64 + lane) * 32;
            *(bf16x8*)dst = pack8(acc, 0); *(bf16x8*)(dst + 16) = pack8(acc, 1);
        }
        for (int i = t; i < 1024; i += NT) {
            *(u32x4*)(KDT + (size_t)ci * 16384 + i * 16) = *(const LAS u32x4*)((const LAS unsigned char*)KDTs + i * 16);
            if (lat) *(u32x4*)(QD + (size_t)ci * 16384 + i * 16) = *(const LAS u32x4*)((const LAS unsigned char*)QDs + i * 16);
        }
    }
#undef PREP_CI
    asm volatile("s_waitcnt vmcnt(0)" ::: "memory");
    __syncthreads();
    if (threadIdx.x == 0) {
        __builtin_amdgcn_fence(__ATOMIC_RELEASE, "agent");
        asm volatile("s_waitcnt vmcnt(0)" ::: "memory");
        (void)__hip_atomic_fetch_add((unsigned*)(a.ws + WS_CTL) + 12288 + 192, 1u, __ATOMIC_RELAXED, __HIP_MEMORY_SCOPE_AGENT);
    }
}
constexpr int SB_WN = 0, SB_QD = 16384, SB_KDT = 32768, SB_AQK = 49152, SBUF = 57344, SB_UB0 = 2 * SBUF;
__device__ __forceinline__ void glds16(const void* gsrc, unsigned lds_dst) { unsigned keep;
    asm volatile("s_mov_b32 %0, m0\n\ts_mov_b32 m0, %2\n\ts_nop 0\n\tglobal_load_lds_dwordx4 %1, off\n\ts_mov_b32 m0, %0" : "=&s"(keep) : "v"(gsrc), "s"(lds_dst) : "memory"); }
#define SCAN_STEP(LAT_) do { \
            const LAS unsigned char* bb = s3 + buf * SBUF; \
            const float gl = *(const LAS float*)(bb + SB_AQK + AQK_GL_OFF); \
            f32x16 U[2]; \
_Pragma("unroll") \
            for (int mt = 0; mt < 2; ++mt) { \
                const LAS u32x4* up = (const LAS u32x4*)(s3 + SB_UB0 + buf * 16384 + ((mt * 4 + sl) * 64 + lane) * 32); \
                const u32x4 u0 = up[0], u1 = up[1]; \
_Pragma("unroll") \
                for (int e = 0; e < 4; ++e) { U[mt][2 * e] = __uint_as_float(u0[e] << 16); U[mt][2 * e + 1] = __uint_as_float(u0[e] & 0xffff0000u); \
                                              U[mt][8 + 2 * e] = __uint_as_float(u1[e] << 16); U[mt][8 + 2 * e + 1] = __uint_as_float(u1[e] & 0xffff0000u); } \
            } \
            f32x16 OT[2]; \
_Pragma("unroll") \
            for (int it = 0; it < 2; ++it) \
_Pragma("unroll") \
                for (int r = 0; r < 16; ++r) OT[it][r] = 0.f; \
_Pragma("unroll") \
            for (int ks = 0; ks < 8; ++ks) { \
                const bf16x8 sb = pack8(S[ks >> 1], ks & 1); \
_Pragma("unroll") \
                for (int mt = 0; mt < 2; ++mt) { \
                    const bf16x8 fw = *(const LAS bf16x8*)(bb + SB_WN + ((2 * ks + hi) * 64 + 32 * mt + r32) * 16); \
                    U[mt] = GDN_MFMA(fw, sb, U[mt]); \
                    if (LAT_) { const bf16x8 fq = *(const LAS bf16x8*)(bb + SB_QD + ((2 * ks + hi) * 64 + 32 * mt + r32) * 16); OT[mt] = GDN_MFMA(sb, fq, OT[mt]); } \
                } \
            } \
            bf16x8 Ub[4]; \
_Pragma("unroll") \
            for (int k2 = 0; k2 < 4; ++k2) Ub[k2] = pack8(U[k2 >> 1], k2 & 1); \
            if (LAT_) { \
_Pragma("unroll") \
                for (int it = 0; it < 2; ++it) \
_Pragma("unroll") \
                    for (int k2 = 0; k2 < 4; ++k2) if (!(it == 0 && k2 >= 2)) { \
                        const bf16x8 fa = *(const LAS bf16x8*)(bb + SB_AQK + ((2 * k2 + hi) * 64 + 32 * it + r32) * 16); \
                        OT[it] = GDN_MFMA(Ub[k2], fa, OT[it]); \
                    } \
_Pragma("unroll") \
                for (int it = 0; it < 2; ++it) { \
                    const int r = gdn_row(d, b, cs, 32 * it + r32); const size_t m = (size_t)b * L + ((r % LT) - LC); \
                    float* op = OGDN + ((size_t)d * M + m) * 512 + h * 128 + 32 * sl + 4 * hi; \
_Pragma("unroll") \
                    for (int q = 0; q < 4; ++q) { const float4 v = make_float4(OT[it][4 * q], OT[it][4 * q + 1], OT[it][4 * q + 2], OT[it][4 * q + 3]); *(float4*)(op + 8 * q) = v; } \
                } \
            } \
_Pragma("unroll") \
            for (int dt = 0; dt < 4; ++dt) { \
_Pragma("unroll") \
                for (int r = 0; r < 16; ++r) S[dt][r] *= gl; \
_Pragma("unroll") \
                for (int k2 = 0; k2 < 4; ++k2) { \
                    const bf16x8 fk = trfrag(bb + SB_KDT, 16 * k2 + 4 * hi, 16 * k2 + 8 + 4 * hi, dt, lane); \
                    S[dt] = GDN_MFMA(fk, Ub[k2], S[dt]); \
                } \
            } \
        } while (0)
__device__ __forceinline__ void scan_item(ArgsRef a, unsigned char* shm, int d, int b, int h) {
    const LAS unsigned char* s3 = (const LAS unsigned char*)shm;
    const unsigned lds0 = (unsigned)(uintptr_t)shm;
    const unsigned char* WN = a.ws + WS_WN; const unsigned char* QD = a.ws + WS_QD; const unsigned char* AQK = a.ws + WS_AQK; const unsigned char* UB = a.ws + WS_UB; const unsigned char* KDT = a.ws + WS_KDT;
    float* OGDN = a.out;
    const int t = tid_fresh(), lane = t & 63, r32 = lane & 31, hi = lane >> 5;
    const int w = __builtin_amdgcn_readfirstlane(t >> 6);
    const bool comp = w < 4; const int sl = w & 3;
    const int ci0 = ((d * NB + b) * 4 + h) * NCH;
    const unsigned lo = (unsigned)(w * 1024 + lane * 16);
#define SCAN_DMA(ci_, buf_) do { const size_t c16_ = (size_t)(ci_) * 16384; const unsigned db_ = lds0 + (buf_) * SBUF + w * 1024; \
        glds16(WN + c16_ + lo, (unsigned)__builtin_amdgcn_readfirstlane(db_ + SB_WN)); glds16(WN + c16_ + 8192 + lo, (unsigned)__builtin_amdgcn_readfirstlane(db_ + SB_WN + 8192)); \
        glds16(QD + c16_ + lo, (unsigned)__builtin_amdgcn_readfirstlane(db_ + SB_QD)); glds16(QD + c16_ + 8192 + lo, (unsigned)__builtin_amdgcn_readfirstlane(db_ + SB_QD + 8192)); \
        glds16(KDT + c16_ + lo, (unsigned)__builtin_amdgcn_readfirstlane(db_ + SB_KDT)); glds16(KDT + c16_ + 8192 + lo, (unsigned)__builtin_amdgcn_readfirstlane(db_ + SB_KDT + 8192)); \
        glds16(AQK + (size_t)(ci_) * 8192 + lo, (unsigned)__builtin_amdgcn_readfirstlane(db_ + SB_AQK)); } while (0)
#define SCAN_UB(ci_, buf_) do { if (!comp) { const u32x4* g_ = (const u32x4*)(UB + (size_t)(ci_) * 16384) + (w - 4) * 256 + lane; LAS u32x4* l_ = (LAS u32x4*)((LAS unsigned char*)shm + SB_UB0 + (buf_) * 16384) + (w - 4) * 256 + lane; \
        const u32x4 x0_ = g_[0], x1_ = g_[64], x2_ = g_[128], x3_ = g_[192]; l_[0] = x0_; l_[64] = x1_; l_[128] = x2_; l_[192] = x3_; } } while (0)
    f32x16 S[4];
#pragma unroll
    for (int dt = 0; dt < 4; ++dt)
#pragma unroll
        for (int r = 0; r < 16; ++r) S[dt][r] = 0.f;
    SCAN_DMA(ci0, 0); SCAN_UB(ci0, 0);
    for (int cs = 0; cs < NCH; ++cs) {
        const int ci = ci0 + cs, buf = cs & 1; const bool lat = cs >= 4;
        asm volatile("s_waitcnt vmcnt(0) lgkmcnt(0)\n\ts_barrier" ::: "memory");
        if (cs + 1 < NCH) { SCAN_DMA(ci + 1, buf ^ 1); SCAN_UB(ci + 1, buf ^ 1); }
        if (comp) { if (lat) SCAN_STEP(true); else SCAN_STEP(false); }
    }
    asm volatile("s_waitcnt vmcnt(0) lgkmcnt(0)\n\ts_barrier" ::: "memory");
#undef SCAN_DMA
#undef SCAN_UB
#undef SCAN_STEP
}
}
__device__ __forceinline__ void ph_gdn_scan(ArgsRef a, unsigned char* shm) {
    if ((int)blockIdx.x < 16) prep_done_wait(a);
    for (int it = blockIdx.x; it < 16; it += gridDim.x) {
        gdn::scan_item(a, shm, it >> 3, (it >> 2) & 1, it & 3);
        if (threadIdx.x == 0) __hip_atomic_fetch_add((unsigned*)(a.ws + WS_CTL) + 12288, 1u, __ATOMIC_RELAXED, __HIP_MEMORY_SCOPE_AGENT);
    }
}
__device__ __forceinline__ void ph_gdn_out(ArgsRef a) {
    const int tix_ = tid_fresh();
    const float* OGDN = a.out; bf16_t* QG = (bf16_t*)(a.ws + WS_QG);
    const float* ML = (const float*)(a.ws + WS_ML);
    const float lam = ((const float*)(a.ws + WS_MOD))[3 * 6144];
    const int lane = tix_ & 63, h = lane >> 4;
    f32x4 gn0 = *(const f32x4*)(a.gdn_norm_g + (lane & 15) * 8), gn1 = *(const f32x4*)(a.gdn_norm_g + (lane & 15) * 8 + 4);
    f32x4 sg0 = *(const f32x4*)(a.subg + (lane & 15) * 8), sg1 = *(const f32x4*)(a.subg + (lane & 15) * 8 + 4);
    for (size_t m = (size_t)blockIdx.x * 8 + (tix_ >> 6); m < (size_t)M; m += (size_t)gridDim.x * 8) {
        const size_t off = m * 512 + lane * 8;
        {
            const f32x4 a0 = *(const f32x4*)(OGDN + off), a1 = *(const f32x4*)(OGDN + off + 4), b0 = *(const f32x4*)(OGDN + (size_t)M * 512 + off), b1 = *(const f32x4*)(OGDN + (size_t)M * 512 + off + 4);
            const f32x4 o0 = a0 + b0, o1 = a1 + b1;
            float ss = (o0[0] * o0[0] + o0[1] * o0[1]) + (o0[2] * o0[2] + o0[3] * o0[3]) + (o1[0] * o1[0] + o1[1] * o1[1]) + (o1[2] * o1[2] + o1[3] * o1[3]);
            ss += __shfl_xor(ss, 1); ss += __shfl_xor(ss, 2); ss += __shfl_xor(ss, 4); ss += __shfl_xor(ss, 8);
            const float rinv = rsqrtf(ss * (1.f / 128.f) + EPS);
            u32x4* gp = (u32x4*)(QG + m * 1024 + 512 + lane * 8);
            const u32x4 gw = *gp;
            float y[8];
#pragma unroll
            for (int e = 0; e < 8; ++e) { const float gv = (e & 1) ? __uint_as_float(gw[e >> 1] & 0xffff0000u) : __uint_as_float(gw[e >> 1] << 16);
                const float ov = e < 4 ? o0[e] : o1[e - 4], gg = e < 4 ? gn0[e] : gn1[e - 4]; y[e] = ov * rinv * gg * siluf(gv); }
            u32x4 w; w.x = pk2(y[0], y[1]); w.y = pk2(y[2], y[3]); w.z = pk2(y[4], y[5]); w.w = pk2(y[6], y[7]);
            *gp = w;
        }
        {
            float on[2][8];
#pragma unroll
            for (int mp = 0; mp < 2; ++mp) {
                const float2 ml0 = *(const float2*)(ML + (((size_t)(0 + mp) * M + m) * 4 + h) * 2), ml1 = *(const float2*)(ML + (((size_t)(2 + mp) * M + m) * 4 + h) * 2);
                const float mx = fmaxf(ml0.x, ml1.x);
                const float w0 = ml0.y * __builtin_amdgcn_exp2f(ml0.x - mx), w1 = ml1.y * __builtin_amdgcn_exp2f(ml1.x - mx);
                const float iw = __builtin_amdgcn_rcpf(w0 + w1);
                const u32x4 p0 = *(const u32x4*)((const bf16_t*)(a.ws + (mp == 0 ? WS_PO0 : WS_PO1)) + off), p1 = *(const u32x4*)((const bf16_t*)(a.ws + (mp == 0 ? WS_PO2 : WS_PO3)) + off);
#pragma unroll
                for (int e = 0; e < 8; ++e) { const float x0 = (e & 1) ? __uint_as_float(p0[e >> 1] & 0xffff0000u) : __uint_as_float(p0[e >> 1] << 16), x1 = (e & 1) ? __uint_as_float(p1[e >> 1] & 0xffff0000u) : __uint_as_float(p1[e >> 1] << 16);
                    on[mp][e] = (w0 * x0 + w1 * x1) * iw; }
            }
            float dd[8]; float ss = 0.f;
#pragma unroll
            for (int e = 0; e < 8; ++e) { dd[e] = on[0][e] - lam * on[1][e]; ss += dd[e] * dd[e]; }
            ss += __shfl_xor(ss, 1); ss += __shfl_xor(ss, 2); ss += __shfl_xor(ss, 4); ss += __shfl_xor(ss, 8);
            const float rinv = rsqrtf(ss * (1.f / 128.f) + EPS) * 0.8f;
            u32x4 w; w.x = pk2(dd[0] * rinv * sg0[0], dd[1] * rinv * sg0[1]); w.y = pk2(dd[2] * rinv * sg0[2], dd[3] * rinv * sg0[3]);
            w.z = pk2(dd[4] * rinv * sg1[0], dd[5] * rinv * sg1[1]); w.w = pk2(dd[6] * rinv * sg1[2], dd[7] * rinv * sg1[3]);
            *(u32x4*)(QG + m * 1024 + lane * 8) = w;
        }
    }
}

__device__ __forceinline__ void ph_topk(ArgsRef a, unsigned* lds) {
    const int tix_ = tid_fresh();
    const float* aff = (const float*)(a.ws + WS_AFF); int* IDXL = (int*)(a.ws + WS_IDXL); float* GATEL = (float*)(a.ws + WS_GATEL); int* SLOT = (int*)(a.ws + WS_SLOT);
    unsigned* hist = lds;
    unsigned* shp = lds + 2048;
    unsigned* wsum = lds + 2052;
    unsigned* wsum2 = lds + 2060;
    unsigned* csum = lds + 2068;
    const int t = tix_, lane = t & 63, w = t >> 6;
    for (int it = blockIdx.x; it < 32; it += gridDim.x) {
        const int e = it & 15, b = it >> 4;
        unsigned key[16];
#pragma unroll
        for (int i = 0; i < 16; ++i) key[i] = __float_as_uint(aff[((size_t)b * L + t * 16 + i) * 16 + e]);
        unsigned prefix = 0, need = 1024;
        for (int pass = 0; pass < 4; ++pass) {
            const int shift = 24 - 8 * pass;
            __syncthreads();
            for (int i = t; i < 2048; i += NT) hist[i] = 0;
            __syncthreads();
            const unsigned himask = pass == 0 ? 0u : (0xffffffffu << (shift + 8));
#pragma unroll
            for (int i = 0; i < 16; ++i) if ((key[i] & himask) == prefix) atomicAdd(&hist[w * 256 + ((key[i] >> shift) & 255)], 1u);
            __syncthreads();
            unsigned hsum = 0, cum = 0;
            if (t < 256) {
#pragma unroll
                for (int ww = 0; ww < 8; ++ww) hsum += hist[ww * 256 + 255 - t];
                cum = hsum;
#pragma unroll
                for (int o = 1; o < 64; o <<= 1) { const unsigned x1 = __shfl_up(cum, o); if (lane >= o) cum += x1; }
                if (lane == 63) csum[w] = cum;
            }
            __syncthreads();
            if (t < 256) {
                unsigned off = 0;
                for (int ww = 0; ww < w; ++ww) off += csum[ww];
                cum += off;
                if (cum >= need && cum - hsum < need) { shp[0] = prefix | ((unsigned)(255 - t) << shift); shp[1] = need - (cum - hsum); }
            }
            __syncthreads();
            prefix = shp[0]; need = shp[1];
        }
        const unsigned thr = prefix;
        unsigned ngt = 0, neq = 0;
#pragma unroll
        for (int i = 0; i < 16; ++i) { ngt += key[i] > thr; neq += key[i] == thr; }
        unsigned sg = ngt, se = neq;
#pragma unroll
        for (int o = 1; o < 64; o <<= 1) { const unsigned x1 = __shfl_up(sg, o), x2 = __shfl_up(se, o); if (lane >= o) { sg += x1; se += x2; } }
        __syncthreads();
        if (lane == 63) { wsum[w] = sg; wsum2[w] = se; }
        __syncthreads();
        unsigned og = 0, oe = 0, total_gt = 0;
        for (int i = 0; i < 8; ++i) { if (i < w) { og += wsum[i]; oe += wsum2[i]; } total_gt += wsum[i]; }
        unsigned pg = og + sg - ngt, pe = oe + se - neq;
        const int grp = b * 16 + e;
#pragma unroll
        for (int i = 0; i < 16; ++i) {
            const int tok = t * 16 + i; int slot = -1;
            if (key[i] > thr) { slot = (int)pg; ++pg; }
            else if (key[i] == thr) { if (pe < need) slot = (int)(total_gt + pe); ++pe; }
            SLOT[((size_t)b * L + tok) * 16 + e] = slot;
            if (slot >= 0) { IDXL[grp * 1024 + slot] = tok; GATEL[grp * 1024 + slot] = __uint_as_float(key[i]); }
        }
    }
}

__device__ __forceinline__ void ph_final(ArgsRef a) {
    const int tix_ = tid_fresh();
    float* xio = a.out; const bf16_t* YE = (const bf16_t*)(a.ws + WS_YE); const int* SLOT = (const int*)(a.ws + WS_SLOT); const float* mod = (const float*)(a.ws + WS_MOD);
    const bf16_t* zrow = (const bf16_t*)(a.ws + WS_CTL + 60 * 1024);
    const int lane = tix_ & 63;
    const int row0 = blockIdx.x * 8 + (tix_ >> 6), rstep = gridDim.x * 8;
    int slotn = -1; float4 xn[4];
    if (row0 < M) { if (lane < 16) slotn = SLOT[(size_t)row0 * 16 + lane];
#pragma unroll
        for (int j = 0; j < 4; ++j) xn[j] = *(const float4*)(xio + (size_t)row0 * D + 4 * lane + 256 * j); }
    for (int row = row0; row < M; row += rstep) {
        const int b = row / L;
        const int slotv = slotn; float4 xc[4];
#pragma unroll
        for (int j = 0; j < 4; ++j) xc[j] = xn[j];
        ushort4 yv[16][4];
#pragma unroll
        for (int e = 0; e < 16; ++e) {
            const int slot = __builtin_amdgcn_readlane(slotv, e);
            const bf16_t* yr = slot >= 0 ? YE + ((size_t)(b * 16 + e) * 1024 + slot) * 1024 : zrow;
#pragma unroll
            for (int j = 0; j < 4; ++j) yv[e][j] = *(const ushort4*)(yr + 4 * lane + 256 * j);
        }
        { const int rn = row + rstep; if (rn < M) { if (lane < 16) slotn = SLOT[(size_t)rn * 16 + lane];
#pragma unroll
            for (int j = 0; j < 4; ++j) xn[j] = *(const float4*)(xio + (size_t)rn * D + 4 * lane + 256 * j); } }
        float acc[16];
#pragma unroll
        for (int i = 0; i < 16; ++i) acc[i] = 0.f;
#pragma unroll
        for (int e = 0; e < 16; ++e)
#pragma unroll
            for (int j = 0; j < 4; ++j) { acc[4 * j] += bf2f(yv[e][j].x); acc[4 * j + 1] += bf2f(yv[e][j].y); acc[4 * j + 2] += bf2f(yv[e][j].z); acc[4 * j + 3] += bf2f(yv[e][j].w); }
        const float* gt2 = mod + b * 6144 + 5120;
        float y[16]; float ss = 0.f;
#pragma unroll
        for (int j = 0; j < 4; ++j) {
            const int k0 = 4 * lane + 256 * j;
            const float4 xv = xc[j], gg = *(const float4*)(gt2 + k0);
            y[4 * j] = xv.x + gg.x * acc[4 * j]; y[4 * j + 1] = xv.y + gg.y * acc[4 * j + 1]; y[4 * j + 2] = xv.z + gg.z * acc[4 * j + 2]; y[4 * j + 3] = xv.w + gg.w * acc[4 * j + 3];
            ss += y[4 * j] * y[4 * j] + y[4 * j + 1] * y[4 * j + 1] + y[4 * j + 2] * y[4 * j + 2] + y[4 * j + 3] * y[4 * j + 3];
        }
        ss = wave_sum(ss);
        const float rinv = rsqrtf(ss * (1.f / D) + EPS);
#pragma unroll
        for (int j = 0; j < 4; ++j) {
            const int k0 = 4 * lane + 256 * j; const float4 gg = *(const float4*)(a.final_g + k0);
            float4 o; o.x = y[4 * j] * rinv * gg.x; o.y = y[4 * j + 1] * rinv * gg.y; o.z = y[4 * j + 2] * rinv * gg.z; o.w = y[4 * j + 3] * rinv * gg.w;
            *(float4*)(xio + (size_t)row * D + k0) = o;
        }
    }
}

__device__ __forceinline__ ArgsRef fresh_args() {
    const unsigned long long p = (unsigned long long)__builtin_amdgcn_kernarg_segment_ptr();
    unsigned lo = (unsigned)p, hi = (unsigned)(p >> 32);
    asm volatile("" : "+s"(lo), "+s"(hi));
    lo = __builtin_amdgcn_readfirstlane(lo); hi = __builtin_amdgcn_readfirstlane(hi);
    return *(const __attribute__((address_space(4))) Args*)(((unsigned long long)hi << 32) | lo);
}
__global__ void __launch_bounds__(NT, 2) fwd_megakernel(Args a_in) {
#define A_ fresh_args()
    extern __shared__ __attribute__((aligned(16))) unsigned char lds_raw[];
    float* ldsf = (float*)lds_raw;
    volatile LAS unsigned* MISC = (volatile LAS unsigned*)((LAS unsigned char*)lds_raw + LDS_MISC);
    if (threadIdx.x < 64) MISC[threadIdx.x] = 0u;
    __syncthreads();
    XcdBarrier bar = xcd_barrier_post((unsigned*)(A_.ws + WS_CTL), MISC + 8);
#define GRID_BAR() xcd_barrier(bar)
    LAS unsigned char* lds3 = (LAS unsigned char*)lds_raw;
    ph_mod(A_, ldsf);
    ph_convert_small(A_, lds_raw);
    GRID_BAR();
    ph_norm<0>(A_, ldsf);
    GRID_BAR();
    { ArgsRef a = A_; unsigned char* ws = a.ws; pg8::Gemm g{(const bf16_t*)(ws + WS_H1), (const bf16_t*)(ws + WS_WIN_T), R, 3584, D, 0, 0, nullptr, 1, 0}; pg8::StaticOrder S; S.init(R, 3584, (int)gridDim.x, (int)blockIdx.x);
      EpiInProj e{(bf16_t*)(ws + WS_QG), (bf16_t*)(ws + WS_K), (bf16_t*)(ws + WS_V), (bf16_t*)(ws + WS_GQKV), (const float*)(ws + WS_ROPE)};
      pg8::gemm_phase<EpiInProj, pg8::StaticOrder, true, true>(lds3, g, S, e); }
    GRID_BAR();
    gdn::prep(A_, lds_raw);
    ph_gdn_scan(A_, lds_raw);
    ph_attn(A_, lds_raw);
    GRID_BAR();
    ph_gdn_out(A_);
    GRID_BAR();
    { ArgsRef a = A_; unsigned char* ws = a.ws; pg8::Gemm g{(const bf16_t*)(ws + WS_QG), (const bf16_t*)(ws + WS_WOUT_T), M, D, D, 0, 0, nullptr, 1, 0}; pg8::StaticOrder S; S.init(M, D, (int)gridDim.x, (int)blockIdx.x);
      EpiOutProj e{a.x, (const float*)(ws + WS_MOD), a.out};
      pg8::gemm_phase<EpiOutProj, pg8::StaticOrder, true, true>(lds3, g, S, e); }
    GRID_BAR();
    ph_norm<1>(A_, ldsf);
    GRID_BAR();
    ph_topk(A_, (unsigned*)ldsf);
    ph_fill_wdown(A_, lds_raw);
    GRID_BAR();
    { ArgsRef a = A_; unsigned char* ws = a.ws; pg8::Gemm g{(const bf16_t*)(ws + WS_H2), (const bf16_t*)(ws + WS_WGU), 32 * 1024, 2048, D, 4, 2048, (const int*)(ws + WS_IDXL), 64, (size_t)L * D * 2};   pg8::StaticOrder S; S.init(32 * 1024, 2048, (int)gridDim.x, (int)blockIdx.x);
      EpiMoeUp e{(bf16_t*)(ws + WS_HID)};
      pg8::gemm_phase<EpiMoeUp, pg8::StaticOrder, true, true, true>(lds3, g, S, e); }
    GRID_BAR();
    { ArgsRef a = A_; unsigned char* ws = a.ws; pg8::Gemm g{(const bf16_t*)(ws + WS_HID), (const bf16_t*)(ws + WS_WD), 32 * 1024, 1024, 1024, 4, 1024, nullptr, 1, 0}; pg8::StaticOrder S; S.init(32 * 1024, 1024, (int)gridDim.x, (int)blockIdx.x);
      EpiMoeDown e{(bf16_t*)(ws + WS_YE), (const float*)(ws + WS_GATEL)};
      pg8::gemm_phase<EpiMoeDown, pg8::StaticOrder, true, true>(lds3, g, S, e); }
    GRID_BAR();
    ph_final(A_);
}

extern "C" void kernel_launch(void* const* d_in, const int* in_sizes, int n_in, void* d_out, int out_size, void* d_ws, size_t ws_size, hipStream_t stream) {
    static int grid = 0;
    if (grid == 0) {
        if (n_in != 24 || out_size != M * D || ws_size < WS_END) { fprintf(stderr, "kernel_launch: unexpected sizes n_in %d out %d ws %zu\n", n_in, out_size, ws_size); grid = -1; return; }
        int dev = 0, cus = 0;
        if (hipGetDevice(&dev) != hipSuccess || hipDeviceGetAttribute(&cus, hipDeviceAttributeMultiprocessorCount, dev) != hipSuccess) { grid = -1; return; }
        if (hipFuncSetAttribute((const void*)fwd_megakernel, hipFuncAttributeMaxDynamicSharedMemorySize, LDS_BYTES) != hipSuccess) { fprintf(stderr, "kernel_launch: hipFuncSetAttribute failed\n"); grid = -1; return; }
        int per_cu = 0;
        if (hipOccupancyMaxActiveBlocksPerMultiprocessor(&per_cu, (const void*)fwd_megakernel, NT, LDS_BYTES) != hipSuccess || per_cu < 1) { fprintf(stderr, "kernel_launch: occupancy query says %d\n", per_cu); }
        (void)hipGetLastError();
        grid = cus;
    }
    if (grid < 0) return;
    (void)hipMemsetAsync((char*)d_ws + WS_CTL, 0, CTL_BYTES, stream);
    Args a{};
    const float** p = (const float**)&a;
    for (int i = 0; i < 24; ++i) p[i] = (const float*)d_in[i];
    a.out = (float*)d_out; a.ws = (unsigned char*)d_ws;
    hipLaunchKernelGGL(fwd_megakernel, dim3(grid), dim3(NT), LDS_BYTES, stream, a);
}
```

```cpp
#include <hip/hip_runtime.h>
#include <stdint.h>
#include <stdio.h>

typedef unsigned short bf16_t;
constexpr int D = 1024, NB = 2, L = 8192, LC = 256, LT = L + LC, R = NB * LT, M = NB * L;
constexpr int INC = 3600;
constexpr int NCH = LT / 64;
constexpr int NCI = 2 * NB * 4 * NCH;
constexpr float EPS = 1e-6f;
constexpr size_t MiB = 1u << 20;
constexpr int NT = 512;
constexpr size_t WS_CTL = 0, CTL_BYTES = 64 * 1024;
constexpr size_t WS_MOD = 128 * 1024;
constexpr size_t WS_ROPE = 256 * 1024;
constexpr size_t WS_WOUT_T = 1 * MiB;
constexpr size_t WS_AFF = 1 * MiB;
constexpr size_t WS_SLOT = 2 * MiB;
constexpr size_t WS_IDXL = 3 * MiB;
constexpr size_t WS_GATEL = 3 * MiB + 256 * 1024;
constexpr size_t WS_G = 4 * MiB;
constexpr size_t WS_BETA = 5 * MiB;
constexpr size_t WS_GL = 6 * MiB;
constexpr size_t WS_AB = 7 * MiB;
constexpr size_t WS_H1 = 10 * MiB;
constexpr size_t WS_WN = 10 * MiB;
constexpr size_t WS_QG = 43 * MiB;
constexpr size_t WS_K = 75 * MiB;
constexpr size_t WS_V = 92 * MiB;
constexpr size_t WS_GQKV = 109 * MiB;
constexpr size_t WS_QD = 159 * MiB;
constexpr size_t WS_AQK = 192 * MiB;
constexpr size_t WS_UB = 209 * MiB;
constexpr size_t WS_KDT = 242 * MiB;
constexpr size_t WS_WIN_T = 292 * MiB;
constexpr size_t WS_PO0 = 109 * MiB, WS_PO1 = 125 * MiB, WS_PO2 = 141 * MiB, WS_PO3 = 275 * MiB;
constexpr size_t WS_ML = 291 * MiB;
constexpr int QB4 = 60, NQ4 = 64 - QB4, NX4 = NB * NQ4 * 128;
constexpr size_t WS_POX = 293 * MiB;
constexpr size_t WS_MLX = 297 * MiB;
constexpr size_t WS_WD = 10 * MiB;
constexpr size_t WS_H2 = 43 * MiB;
constexpr size_t WS_XE = 75 * MiB;
constexpr size_t WS_YE = 75 * MiB;
constexpr size_t WS_HID = 139 * MiB;
constexpr size_t WS_WGU = 209 * MiB;
constexpr size_t WS_END = 299 * MiB;
constexpr int LDS_BYTES = 160 * 1024;
constexpr int LDS_MISC = LDS_BYTES - 256;

#define LAS __attribute__((address_space(3)))
__device__ __forceinline__ bf16_t f2bf(float f) { unsigned u = __float_as_uint(f); u += 0x7fffu + ((u >> 16) & 1u); return (bf16_t)(u >> 16); }
__device__ __forceinline__ float bf2f(bf16_t h) { return __uint_as_float(((unsigned)h) << 16); }
__device__ __forceinline__ float siluf(float x) { return x * __builtin_amdgcn_rcpf(1.f + __expf(-x)); }
__device__ __forceinline__ float wave_sum(float v) {
#pragma unroll
    for (int o = 1; o < 64; o <<= 1) v += __shfl_xor(v, o);
    return v;
}

typedef float f32x4 __attribute__((ext_vector_type(4)));
typedef float f32x2_cv __attribute__((ext_vector_type(2))); typedef __bf16 bf16x2_cv __attribute__((ext_vector_type(2)));
__device__ __forceinline__ unsigned cvt2bf(float lo, float hi) { f32x2_cv v = {lo, hi}; bf16x2_cv b = __builtin_convertvector(v, bf16x2_cv); return __builtin_bit_cast(unsigned, b); }
__device__ __forceinline__ int tid_fresh() { int t = threadIdx.x; asm volatile("" : "+v"(t)); return t; }
#define XB_TMO      128
#define XB_XCNT(j)  (256  + 64 * (j))
#define XB_XSUB(j)  (1280 + 64 * (j))
#define XB_XGEN(j)  (2304 + 64 * (j))
#define XB_TOP      3328
#define XB_TOPGEN   3392
#define XCD_BAR_WORDS 3456
#define XB_SPIN_CAP (1u << 22)
__device__ __forceinline__ unsigned xb_ld(unsigned* p)              { return __hip_atomic_load(p, __ATOMIC_RELAXED, __HIP_MEMORY_SCOPE_AGENT); }
__device__ __forceinline__ unsigned xb_add(unsigned* p, unsigned v) { return __hip_atomic_fetch_add(p, v, __ATOMIC_RELAXED, __HIP_MEMORY_SCOPE_AGENT); }
__device__ __forceinline__ unsigned xb_xcc_id() { return (unsigned)__builtin_amdgcn_s_getreg((3 << 11) | 20) & 0xFu; }
#define XB_SPIN(cond, bar) do { unsigned _sp = 0; while (cond) { __builtin_amdgcn_s_sleep(1); \
    if ((++_sp & 255u) == 0u) { if (xb_ld(&(bar)[XB_TMO])) break; if (_sp > XB_SPIN_CAP) { atomicAdd(&(bar)[XB_TMO], 1u); break; } } } } while (0)
struct XcdBarrier { unsigned* bar; unsigned x; volatile LAS unsigned* st; };
__device__ __forceinline__ XcdBarrier xcd_barrier_post(unsigned* bar, volatile LAS unsigned* st) {
    XcdBarrier b; b.bar = bar; b.x = xb_xcc_id(); b.st = st;
    if (threadIdx.x == 0) (void)xb_add(&bar[XB_XCNT(b.x)], 1u);
    return b;
}
__device__ __forceinline__ void xcd_barrier_complete(unsigned* bar, unsigned x, unsigned& nloc, unsigned& nx) {
    const unsigned G = gridDim.x * gridDim.y * gridDim.z;
    unsigned sum, cnt, mine, sp = 0u;
    for (;;) {
        sum = 0u; cnt = 0u; mine = 0u;
#pragma unroll
        for (unsigned j = 0; j < 16; ++j) { const unsigned c = xb_ld(&bar[XB_XCNT(j)]); sum += c; cnt += (c > 0u) ? 1u : 0u; mine = (j == x) ? c : mine; }
        if (sum == G) break;
        __builtin_amdgcn_s_sleep(1);
        if ((++sp & 255u) == 0u) { if (xb_ld(&bar[XB_TMO])) break; if (sp > XB_SPIN_CAP) { atomicAdd(&bar[XB_TMO], 1u); break; } }
    }
    nloc = mine > 0u ? mine : 1u; nx = cnt > 0u ? cnt : 1u;
}
__device__ __forceinline__ void xcd_barrier(const XcdBarrier& b) {
    asm volatile("s_waitcnt vmcnt(0)" ::: "memory");
    __syncthreads();
    if (threadIdx.x == 0) {
        unsigned* bar = b.bar;
        __builtin_amdgcn_s_waitcnt(0);
        unsigned nloc = b.st[0], nx = b.st[1];
        if (nloc == 0u) { xcd_barrier_complete(bar, b.x, nloc, nx); b.st[0] = nloc; b.st[1] = nx; }
        const unsigned old = xb_add(&bar[XB_XSUB(b.x)], 1u);
        const unsigned gen = old / nloc;
        if (old + 1u == (gen + 1u) * nloc) {
            __builtin_amdgcn_fence(__ATOMIC_RELEASE, "agent");
            asm volatile("s_waitcnt vmcnt(0)" ::: "memory");
            const unsigned og = xb_add(&bar[XB_TOP], 1u);
            const unsigned tg = og / nx;
            if (og + 1u == (tg + 1u) * nx) xb_add(&bar[XB_TOPGEN], 1u);
            else XB_SPIN(xb_ld(&bar[XB_TOPGEN]) == tg, bar);
            __builtin_amdgcn_fence(__ATOMIC_ACQUIRE, "agent");
            xb_add(&bar[XB_XGEN(b.x)], 1u);
            asm volatile("s_waitcnt vmcnt(0)" ::: "memory");
        } else {
            XB_SPIN(xb_ld(&bar[XB_XGEN(b.x)]) == gen, bar);
            __builtin_amdgcn_fence(__ATOMIC_ACQUIRE, "agent");
            asm volatile("s_waitcnt vmcnt(0)" ::: "memory");
        }
    }
    __syncthreads();
}

struct Args {
    const float *x, *c, *ctx, *c_ctx, *w_mod, *b_mod, *norm1_g, *w_in, *conv_w, *a_log, *dt_bias, *gdn_norm_g;
    const float *lq1, *lk1, *lq2, *lk2, *subg, *w_out, *norm2_g, *w_router, *w_gate, *w_up, *w_down, *final_g;
    float* out; unsigned char* ws;
};
typedef const __attribute__((address_space(4))) Args& ArgsRef;

__device__ __forceinline__ void ph_mod(ArgsRef a, float* lds) {
    const int tix_ = tid_fresh();
    float* s = lds;
    float* red = lds + 3072;
    float* mod = (float*)(a.ws + WS_MOD);
    const int t = tix_;
    for (int i = t; i < 1024; i += NT) { s[i] = siluf(a.c[i]); s[1024 + i] = siluf(a.c[1024 + i]); s[2048 + i] = siluf(a.c_ctx[i]); }
    __syncthreads();
    const int rq = t & 7, kg = t >> 3;
    for (int it = blockIdx.x; it < 256; it += gridDim.x) {
        const int n0 = it * 24;
        f32x4 a0 = {0.f, 0.f, 0.f, 0.f}, a1 = a0, a2 = a0;
        if (rq < 6) {
            f32x4 wv[16];
#pragma unroll
            for (int j = 0; j < 16; ++j) wv[j] = *(const f32x4*)(a.w_mod + (size_t)(kg + 64 * j) * 6144 + n0 + 4 * rq);
#pragma unroll
            for (int j = 0; j < 16; ++j) { const int k = kg + 64 * j; a0 += wv[j] * s[k]; a1 += wv[j] * s[1024 + k]; a2 += wv[j] * s[2048 + k]; }
#pragma unroll
            for (int e = 0; e < 4; ++e) { red[(kg * 3 + 0) * 24 + 4 * rq + e] = a0[e]; red[(kg * 3 + 1) * 24 + 4 * rq + e] = a1[e]; red[(kg * 3 + 2) * 24 + 4 * rq + e] = a2[e]; }
        }
        __syncthreads();
        if (t < 72) {
            const int v = t / 24, cc = t % 24; float acc = a.b_mod[n0 + cc];
            for (int g = 0; g < 64; ++g) acc += red[(g * 3 + v) * 24 + cc];
            mod[v * 6144 + n0 + cc] = acc;
        }
        __syncthreads();
    }
    if (blockIdx.x == 0 && t == 0) {
        float s1 = 0.f, s2 = 0.f;
        for (int i = 0; i < 64; ++i) { s1 += a.lq1[i] * a.lk1[i]; s2 += a.lq2[i] * a.lk2[i]; }
        mod[3 * 6144] = expf(s1) - expf(s2) + 0.2f;
    }
}

template <int MODE>
__device__ __forceinline__ void ph_norm(ArgsRef a, float* lds) {
    const int tix_ = tid_fresh();
    {
        const float* wsrc0 = MODE == 0 ? a.w_in + 3584 : a.w_router; const int wld0 = MODE == 0 ? INC : 16;
        __syncthreads();
        for (int k = tix_; k < 1024; k += NT) {
            const float4* wr = (const float4*)(wsrc0 + (size_t)k * wld0);
            const float4 w0 = wr[0], w1 = wr[1], w2 = wr[2], w3 = wr[3];
            lds[0 * 1024 + k] = w0.x; lds[1 * 1024 + k] = w0.y; lds[2 * 1024 + k] = w0.z; lds[3 * 1024 + k] = w0.w;
            lds[4 * 1024 + k] = w1.x; lds[5 * 1024 + k] = w1.y; lds[6 * 1024 + k] = w1.z; lds[7 * 1024 + k] = w1.w;
            lds[8 * 1024 + k] = w2.x; lds[9 * 1024 + k] = w2.y; lds[10 * 1024 + k] = w2.z; lds[11 * 1024 + k] = w2.w;
            lds[12 * 1024 + k] = w3.x; lds[13 * 1024 + k] = w3.y; lds[14 * 1024 + k] = w3.z; lds[15 * 1024 + k] = w3.w;
        }
        __syncthreads();
    }
    const float* mod = (const float*)(a.ws + WS_MOD);
    bf16_t* out = (bf16_t*)(a.ws + (MODE == 0 ? WS_H1 : WS_H2));
    float* aff = (float*)(a.ws + WS_AFF);
    const float* g = MODE == 0 ? a.norm1_g : a.norm2_g;
    const int lane = tix_ & 63;
    const int nrows = MODE == 0 ? R : M;
    for (int row = blockIdx.x * 8 + (tix_ >> 6); row < nrows; row += gridDim.x * 8) {
        const float* src; int mv;
        if (MODE == 0) { const int b = row / LT, j = row % LT; if (j < LC) { src = a.ctx + ((size_t)b * LC + j) * D; mv = 2; } else { src = a.x + ((size_t)b * L + (j - LC)) * D; mv = b; } }
        else { src = a.out + (size_t)row * D; mv = row / L; }
        const float* sh = mod + mv * 6144 + (MODE == 0 ? 0 : 3072);
        const float* sc = sh + 1024;
        float4 v[4]; float ss = 0.f;
#pragma unroll
        for (int j = 0; j < 4; ++j) { v[j] = *(const float4*)(src + 4 * lane + 256 * j); ss += v[j].x * v[j].x + v[j].y * v[j].y + v[j].z * v[j].z + v[j].w * v[j].w; }
        ss = wave_sum(ss);
        const float rinv = rsqrtf(ss * (1.f / D) + EPS);
        float y[16];
#pragma unroll
        for (int j = 0; j < 4; ++j) {
            const int k0 = 4 * lane + 256 * j;
            const float4 gg = *(const float4*)(g + k0), s1 = *(const float4*)(sc + k0), s0 = *(const float4*)(sh + k0);
            y[4 * j + 0] = v[j].x * rinv * gg.x * (1.f + s1.x) + s0.x;
            y[4 * j + 1] = v[j].y * rinv * gg.y * (1.f + s1.y) + s0.y;
            y[4 * j + 2] = v[j].z * rinv * gg.z * (1.f + s1.z) + s0.z;
            y[4 * j + 3] = v[j].w * rinv * gg.w * (1.f + s1.w) + s0.w;
            ushort4 o; o.x = f2bf(y[4 * j + 0]); o.y = f2bf(y[4 * j + 1]); o.z = f2bf(y[4 * j + 2]); o.w = f2bf(y[4 * j + 3]);
            *(ushort4*)(out + (size_t)row * D + k0) = o;
        }
        {
            float lg[16];
#pragma unroll
            for (int e = 0; e < 16; ++e) {
                float acc = 0.f;
#pragma unroll
                for (int j = 0; j < 4; ++j) { const float4 w = *(const float4*)(lds + e * 1024 + 4 * lane + 256 * j);
                    acc += y[4 * j] * w.x + y[4 * j + 1] * w.y + y[4 * j + 2] * w.z + y[4 * j + 3] * w.w; }
                lg[e] = acc;
                if ((e & 3) == 3) asm volatile("" ::: "memory");
            }
            float v8[8], v4[4], v2[2], mine;
            { const bool up = lane & 32;
#pragma unroll
              for (int i = 0; i < 8; ++i) { const float keep = up ? lg[8 + i] : lg[i], send = up ? lg[i] : lg[8 + i]; v8[i] = keep + __shfl_xor(send, 32); } }
            { const bool up = lane & 16;
#pragma unroll
              for (int i = 0; i < 4; ++i) { const float keep = up ? v8[4 + i] : v8[i], send = up ? v8[i] : v8[4 + i]; v4[i] = keep + __shfl_xor(send, 16); } }
            { const bool up = lane & 8;
#pragma unroll
              for (int i = 0; i < 2; ++i) { const float keep = up ? v4[2 + i] : v4[i], send = up ? v4[i] : v4[2 + i]; v2[i] = keep + __shfl_xor(send, 8); } }
            { const bool up = lane & 4; const float keep = up ? v2[1] : v2[0], send = up ? v2[0] : v2[1]; mine = keep + __shfl_xor(send, 4); }
            mine += __shfl_xor(mine, 2); mine += __shfl_xor(mine, 1);
            const int ecol = ((lane >> 5) & 1) * 8 + ((lane >> 4) & 1) * 4 + ((lane >> 3) & 1) * 2 + ((lane >> 2) & 1);
            if (MODE == 0) {
                if ((lane & 3) == 0) ((float*)(a.ws + WS_AB))[(size_t)row * 16 + ecol] = mine;
            } else {
                float mx = mine;
                mx = fmaxf(mx, __shfl_xor(mx, 4)); mx = fmaxf(mx, __shfl_xor(mx, 8)); mx = fmaxf(mx, __shfl_xor(mx, 16)); mx = fmaxf(mx, __shfl_xor(mx, 32));
                const float ex = expf(mine - mx);
                float sum = ex;
                sum += __shfl_xor(sum, 4); sum += __shfl_xor(sum, 8); sum += __shfl_xor(sum, 16); sum += __shfl_xor(sum, 32);
                if ((lane & 3) == 0) aff[(size_t)row * 16 + ecol] = ex / sum;
            }
        }
    }
}

namespace pg8 {
#define PG8_LAS __attribute__((address_space(3)))
typedef unsigned short bf16_t;
typedef short bf16x8 __attribute__((ext_vector_type(8)));
typedef float f32x4 __attribute__((ext_vector_type(4)));
typedef unsigned u32x4 __attribute__((ext_vector_type(4)));
constexpr int BM = 256, BK = 64, HALF = 128, HTB = HALF * BK * 2  , STAGE_BYTES = 8 * HTB, NXCD = 8, WGM = 8;

__host__ __device__ __forceinline__ int lds_byte(int r, int c) { const int st = (r >> 4) * 2 + (c >> 5), rr = r & 15, cc = c & 31, ob = rr * 64 + cc * 2; return st * 1024 + (ob ^ (((ob >> 9) & 1) << 5)); }
__host__ __device__ __forceinline__ void stage_rc(int b, int& R, int& C) { const int st = b / 1024, sb = b % 1024, swz = sb ^ (((sb >> 9) & 1) << 5); R = (st >> 1) * 16 + swz / 64; C = (st & 1) * 32 + (swz % 64) / 2; }
__host__ __device__ __forceinline__ int perm32(int rho) { const int n = rho >> 4, i = rho & 15; return 8 * (i >> 2) + 4 * n + (i & 3); }

struct Unit { int pm, pn; };
struct Gemm { const bf16_t* A; const bf16_t* Bt; int M, N, K; int grp_tiles, grp_rows; const int* idx; int tpb; size_t bstride;
    __host__ __device__ __forceinline__ size_t boff(const Unit& u) const { return ((size_t)(grp_tiles ? ((u.pm / grp_tiles) & 15) * grp_rows : 0) + (size_t)u.pn * BM) * (size_t)K * 2; } };

struct StaticOrder {
    int nM, nN, nwg, G, c;
    __host__ __device__ void init(int M, int N, int G_, int c_) { nM = M / BM; nN = N / BM; nwg = nM * nN; G = G_; c = c_; }
    __host__ __device__ bool next(int i, Unit& u) const {
        const long L = (long)i * G + c; if (L >= nwg) return false;
        int wgid = (int)L; { const int q = nwg / NXCD, r = nwg % NXCD, xcd = wgid % NXCD, off = wgid / NXCD; wgid = (xcd < r ? xcd * (q + 1) : r * (q + 1) + (xcd - r) * q) + off; }
        const int nig = WGM * nN, gid = wgid / nig, fm = gid * WGM, gsz = (nM - fm) < WGM ? (nM - fm) : WGM;
        u.pm = fm + ((wgid % nig) % gsz); u.pn = (wgid % nig) / gsz; return true;
    }
    __device__ __forceinline__ void a_ready(const Unit&) const {}
    __device__ __forceinline__ void done(const Unit&) const {}
};

__device__ __forceinline__ unsigned cvt_pk_bf16(float lo, float hi) { return cvt2bf(lo, hi); }
typedef float f32x2 __attribute__((ext_vector_type(2)));

template <class Epi, class Sched, bool ALIGN_EPI = false, bool SP2 = false, bool GATHER = false>
__device__ __forceinline__ void gemm_phase(PG8_LAS unsigned char* lds, const Gemm g, const Sched& S, const Epi& E) {
    const int tid = tid_fresh(), wid = __builtin_amdgcn_readfirstlane(tid >> 6), lane = tid & 63, wr = wid >> 2, wc = wid & 3, fr = lane & 15, fq = lane >> 4;
    const int K = g.K, nt = K / BK;
    unsigned voffA[2], voffB[2];
#pragma unroll
    for (int i = 0; i < 2; ++i) { int R, C; stage_rc(tid * 16 + i * 8192, R, C); const int Rb = Epi::PERM ? ((R & ~31) + perm32(R & 31)) : R;
        voffA[i] = (unsigned)(R * K + C) * 2u; voffB[i] = (unsigned)(Rb * K + C) * 2u; }
    const size_t kstep = (size_t)(BK * 2);
    const size_t hstep = (size_t)HALF * K * 2;
    const size_t tstep = 2 * hstep;
    const unsigned ldsw = (unsigned)wid * 1024u;
    const int aoff = lds_byte(wr * 64 + fr, fq * 8), boff = lds_byte(wc * 32 + fr, fq * 8);
#define PG8_SA(b, h) (((b) * 2 + (h)) * HTB)
#define PG8_SB(b, h) ((4 + (b) * 2 + (h)) * HTB)
#define PG8_STAGE(bufoff, gbase, voff) do { _Pragma("unroll") for (int _i = 0; _i < 2; ++_i) \
        __builtin_amdgcn_global_load_lds((const unsigned*)((const char*)(gbase) + (voff)[_i]), (PG8_LAS unsigned*)(lds + (bufoff) + ldsw + _i * 8192), 16, 0, 0); } while (0)
#define PG8_LDA(dst, b, h) do { _Pragma("unroll") for (int m = 0; m < 4; ++m) _Pragma("unroll") for (int k = 0; k < 2; ++k) dst[m][k] = *(const PG8_LAS bf16x8*)(lds + PG8_SA(b, h) + aoff + m * 2048 + k * 1024); } while (0)
#define PG8_LDB(dst, b, h) do { _Pragma("unroll") for (int n = 0; n < 2; ++n) _Pragma("unroll") for (int k = 0; k < 2; ++k) dst[n][k] = *(const PG8_LAS bf16x8*)(lds + PG8_SB(b, h) + boff + n * 2048 + k * 1024); } while (0)
#define PG8_MMA(ai, bj, At, Bt) do { __builtin_amdgcn_s_setprio(1); _Pragma("unroll") for (int m = 0; m < 4; ++m) _Pragma("unroll") for (int n = 0; n < 2; ++n) _Pragma("unroll") for (int k = 0; k < 2; ++k) \
        acc[ai][bj][m][n] = __builtin_amdgcn_mfma_f32_16x16x32_bf16(Bt[n][k], At[m][k], acc[ai][bj][m][n], 0, 0, 0); __builtin_amdgcn_s_setprio(0); } while (0)
#define PG8_WAIT_V(n) asm volatile("s_waitcnt vmcnt(" #n ")" ::: "memory")
#define PG8_WAIT_L(n) asm volatile("s_waitcnt lgkmcnt(" #n ")" ::: "memory")
#define PG8_BAR __builtin_amdgcn_s_barrier()
#define PG8_SCHED __builtin_amdgcn_sched_barrier(0)
    Unit cur, nxt; int ui = 0;
    if (!S.next(0, cur)) return;
    f32x4 acc[2][2][4][2];
#pragma unroll
    for (int a = 0; a < 2; ++a)
#pragma unroll
        for (int b = 0; b < 2; ++b)
#pragma unroll
            for (int m = 0; m < 4; ++m)
#pragma unroll
                for (int n = 0; n < 2; ++n) acc[a][b][m][n] = (f32x4){0.f, 0.f, 0.f, 0.f};
    bf16x8 At[4][2], B0[2][2], B1[2][2];
    unsigned vA0[2], vA1[2], nvA0[2], nvA1[2];
    int rA[2], cA2[2];
#pragma unroll
    for (int i = 0; i < 2; ++i) { int R, C; stage_rc(tid * 16 + i * 8192, R, C); rA[i] = R; cA2[i] = C * 2; }
#define PG8_AOFF(u_, o0_, o1_) do { _Pragma("unroll") for (int i_ = 0; i_ < 2; ++i_) { \
        if (GATHER) { o0_[i_] = (unsigned)g.idx[(u_).pm * BM + rA[i_]] * (unsigned)(K * 2) + cA2[i_]; o1_[i_] = (unsigned)g.idx[(u_).pm * BM + HALF + rA[i_]] * (unsigned)(K * 2) + cA2[i_]; } \
        else { o0_[i_] = voffA[i_]; o1_[i_] = voffA[i_] + (unsigned)hstep; } } } while (0)
#define PG8_ABASE(u_) (GATHER ? (const char*)g.A + (size_t)((u_).pm / g.tpb) * g.bstride : (const char*)g.A + (size_t)(u_).pm * tstep)
    PG8_AOFF(cur, vA0, vA1);
    const char* cA = PG8_ABASE(cur); const char* cB = (const char*)g.Bt + g.boff(cur);
    S.a_ready(cur);
    if constexpr (SP2) {
        PG8_STAGE(PG8_SB(0, 0), cB, voffB); PG8_STAGE(PG8_SB(0, 1), cB + hstep, voffB); PG8_STAGE(PG8_SA(0, 0), cA, vA0); PG8_STAGE(PG8_SA(0, 1), cA, vA1);
        if (wr == 1) PG8_BAR;
        PG8_WAIT_V(2); PG8_BAR;
        PG8_STAGE(PG8_SB(1, 0), cB + kstep, voffB); PG8_STAGE(PG8_SA(1, 0), cA + kstep, vA0); PG8_STAGE(PG8_SB(1, 1), cB + hstep + kstep, voffB);
        PG8_WAIT_V(6); PG8_BAR;
    } else {
        PG8_STAGE(PG8_SB(0, 0), cB, voffB); PG8_STAGE(PG8_SA(0, 0), cA, vA0); PG8_STAGE(PG8_SB(0, 1), cB + hstep, voffB); PG8_STAGE(PG8_SA(0, 1), cA, vA1);
        if (wr == 1) PG8_BAR;
        PG8_WAIT_V(4); PG8_BAR;
        PG8_STAGE(PG8_SB(1, 0), cB + kstep, voffB); PG8_STAGE(PG8_SA(1, 0), cA + kstep, vA0); PG8_STAGE(PG8_SB(1, 1), cB + hstep + kstep, voffB);
        PG8_WAIT_V(6); PG8_BAR;
    }
    for (;;) {
        const bool has_next = S.next(ui + 1, nxt);
        const char* nA = has_next ? PG8_ABASE(nxt) : cA; const char* nB = has_next ? (const char*)g.Bt + g.boff(nxt) : cB;
        if (has_next) PG8_AOFF(nxt, nvA0, nvA1); else { nvA0[0] = vA0[0]; nvA0[1] = vA0[1]; nvA1[0] = vA1[0]; nvA1[1] = vA1[1]; }
        for (int t = 0; t < nt; t += 2) {
            const bool last = (t == nt - 2);
            const char* a1 = cA + (size_t)(t + 1) * kstep;
            const char* a2 = last ? nA : cA + (size_t)(t + 2) * kstep; const char* b2 = last ? nB : cB + (size_t)(t + 2) * kstep;
            const char* a3 = a2 + kstep; const char* b3 = b2 + kstep;
            unsigned sA0[2], sA1[2]; sA0[0] = last ? nvA0[0] : vA0[0]; sA0[1] = last ? nvA0[1] : vA0[1]; sA1[0] = last ? nvA1[0] : vA1[0]; sA1[1] = last ? nvA1[1] : vA1[1];
            if (last && has_next) S.a_ready(nxt);
            if constexpr (SP2) {
            PG8_LDB(B0, 0, 0); PG8_LDB(B1, 0, 1); PG8_SCHED; PG8_LDA(At, 0, 0); PG8_STAGE(PG8_SA(1, 1), a1, vA1);
            PG8_WAIT_V(8); PG8_WAIT_L(0); PG8_BAR; PG8_MMA(0, 0, At, B0); PG8_MMA(0, 1, At, B1); PG8_BAR; PG8_SCHED;
            PG8_LDA(At, 0, 1); PG8_STAGE(PG8_SB(0, 0), b2, voffB); PG8_STAGE(PG8_SB(0, 1), b2 + hstep, voffB); PG8_STAGE(PG8_SA(0, 0), a2, sA0);
            PG8_WAIT_V(8); PG8_WAIT_L(0); PG8_BAR; PG8_MMA(1, 0, At, B0); PG8_MMA(1, 1, At, B1); PG8_BAR; PG8_SCHED;
            PG8_LDB(B0, 1, 0); PG8_LDB(B1, 1, 1); PG8_SCHED; PG8_LDA(At, 1, 0); PG8_STAGE(PG8_SA(0, 1), a2, sA1);
            PG8_WAIT_V(8); PG8_WAIT_L(0); PG8_BAR; PG8_MMA(0, 0, At, B0); PG8_MMA(0, 1, At, B1); PG8_BAR; PG8_SCHED;
            PG8_LDA(At, 1, 1); PG8_STAGE(PG8_SB(1, 0), b3, voffB); PG8_STAGE(PG8_SB(1, 1), b3 + hstep, voffB); PG8_STAGE(PG8_SA(1, 0), a3, sA0);
            PG8_WAIT_V(8); PG8_WAIT_L(0); PG8_BAR; PG8_MMA(1, 0, At, B0); PG8_MMA(1, 1, At, B1); PG8_BAR; PG8_SCHED;
            } else {
            PG8_LDB(B0, 0, 0); PG8_SCHED; PG8_LDA(At, 0, 0); PG8_STAGE(PG8_SA(1, 1), a1, vA1);
            PG8_WAIT_L(8); PG8_BAR; PG8_WAIT_L(0); PG8_MMA(0, 0, At, B0); PG8_BAR; PG8_SCHED;
            PG8_LDB(B1, 0, 1); PG8_STAGE(PG8_SB(0, 0), b2, voffB);
            PG8_BAR; PG8_WAIT_L(0); PG8_MMA(0, 1, At, B1); PG8_BAR;
            PG8_LDA(At, 0, 1); PG8_STAGE(PG8_SA(0, 0), a2, sA0);
            PG8_BAR; PG8_WAIT_L(0); PG8_MMA(1, 0, At, B0); PG8_BAR; PG8_SCHED;
            PG8_STAGE(PG8_SB(0, 1), b2 + hstep, voffB);
            PG8_WAIT_V(6); PG8_BAR; PG8_MMA(1, 1, At, B1); PG8_BAR;
            PG8_LDB(B0, 1, 0); PG8_SCHED; PG8_LDA(At, 1, 0); PG8_STAGE(PG8_SA(0, 1), a2, sA1);
            PG8_WAIT_L(8); PG8_BAR; PG8_WAIT_L(0); PG8_MMA(0, 0, At, B0); PG8_BAR; PG8_SCHED;
            PG8_LDB(B1, 1, 1); PG8_STAGE(PG8_SB(1, 0), b3, voffB);
            PG8_BAR; PG8_WAIT_L(0); PG8_MMA(0, 1, At, B1); PG8_BAR;
            PG8_LDA(At, 1, 1); PG8_STAGE(PG8_SA(1, 0), a3, sA0);
            PG8_BAR; PG8_WAIT_L(0); PG8_MMA(1, 0, At, B0); PG8_BAR; PG8_SCHED;
            PG8_STAGE(PG8_SB(1, 1), b3 + hstep, voffB);
            PG8_WAIT_V(6); PG8_BAR; PG8_MMA(1, 1, At, B1); PG8_BAR;
            }
        }
        if constexpr (ALIGN_EPI) { if (wr == 0) PG8_BAR; }
        if constexpr (!Epi::AFTER_DRAIN) { E(acc, cur, wr, wc, fr, fq); S.done(cur); }
        if (!has_next) break;
#pragma unroll
        for (int a = 0; a < 2; ++a)
#pragma unroll
            for (int b = 0; b < 2; ++b)
#pragma unroll
                for (int m = 0; m < 4; ++m)
#pragma unroll
                    for (int n = 0; n < 2; ++n) acc[a][b][m][n] = (f32x4){0.f, 0.f, 0.f, 0.f};
        cur = nxt; cA = nA; cB = nB; ++ui; vA0[0] = nvA0[0]; vA0[1] = nvA0[1]; vA1[0] = nvA1[0]; vA1[1] = nvA1[1];
        if constexpr (ALIGN_EPI) { if (wr == 1) PG8_BAR; }
    }
    PG8_WAIT_V(0);
    if constexpr (!ALIGN_EPI) { if (wr == 0) PG8_BAR; }
    PG8_BAR;
    if constexpr (Epi::AFTER_DRAIN) { E.fused(acc, cur, wr, wc, fr, fq, lds, wid, lane); S.done(cur); }
#undef PG8_SA
#undef PG8_SB
#undef PG8_STAGE
#undef PG8_AOFF
#undef PG8_ABASE
#undef PG8_LDA
#undef PG8_LDB
#undef PG8_MMA
#undef PG8_WAIT_V
#undef PG8_WAIT_L
#undef PG8_BAR
#undef PG8_SCHED
}
}

using pg8::u32x4; using pg8::Unit;
typedef unsigned u32x2 __attribute__((ext_vector_type(2)));
struct EpiInProj {
    static constexpr bool PERM = true, AFTER_DRAIN = false;
    bf16_t *QG, *Kb, *Vb, *GQKV; const float* rope;
    __device__ __forceinline__ void operator()(const f32x4 (&acc)[2][2][4][2], const Unit& u, int wr, int wc, int fr, int fq) const {
        const int b = u.pm / 33; const bool isctx = (u.pm % 33) == 0; const int pn = u.pn;
        bf16_t* base; int ld, rowoff = 0, colt; bool do_rope = false; float sc = 1.f;
        if (pn < 2) { if (isctx) return; base = QG; ld = 1024; rowoff = 256 * (b + 1); colt = pn * 256; do_rope = true; sc = 0.125f * 1.4426950408889634f; }
        else if (pn < 4) { base = Kb; ld = 512; colt = (pn - 2) * 256; do_rope = !isctx; }
        else if (pn < 6) { base = Vb; ld = 512; colt = (pn - 4) * 256; }
        else if (pn < 12) { base = GQKV; ld = 1536; colt = (pn - 6) * 256; }
        else { if (isctx) return; base = QG; ld = 1024; rowoff = 256 * (b + 1); colt = 512 + (pn - 12) * 256; }
        const int col0 = colt + wc * 32 + 8 * fq;
        const float sgn = fq < 2 ? -1.f : 1.f;
#pragma unroll
        for (int ai = 0; ai < 2; ++ai)
#pragma unroll
            for (int m = 0; m < 4; ++m) {
                const int r = u.pm * 256 + ai * 128 + wr * 64 + m * 16 + fr;
                bf16_t* rowp = base + (size_t)(r - rowoff) * ld + col0;
                if (do_rope) {
                    const int tt = r - b * LT - LC; const int pos = (wc & 1) ? (tt & 63) : (tt >> 6);
                    const float4* tp = (const float4*)(rope + (pos * 16 + 8 * (fq & 1)) * 2);
                    const float4 t0 = tp[0], t1 = tp[1], t2 = tp[2], t3 = tp[3];
                    const float cs[8] = {t0.x, t0.z, t1.x, t1.z, t2.x, t2.z, t3.x, t3.z}, sn[8] = {t0.y, t0.w, t1.y, t1.w, t2.y, t2.w, t3.y, t3.w};
#pragma unroll
                    for (int bj = 0; bj < 2; ++bj) {
                        const f32x4 v0 = acc[ai][bj][m][0], v1 = acc[ai][bj][m][1];
                        const float xv[8] = {v0[0], v0[1], v0[2], v0[3], v1[0], v1[1], v1[2], v1[3]}; float y[8];
#pragma unroll
                        for (int i = 0; i < 8; ++i) { auto sw_ = __builtin_amdgcn_permlane32_swap(__float_as_uint(xv[i]), __float_as_uint(xv[i]), false, false);
                            const float o = __uint_as_float(fq < 2 ? sw_[1] : sw_[0]); y[i] = (xv[i] * cs[i] + sgn * o * sn[i]) * sc; }
                        u32x4 w; w.x = pg8::cvt_pk_bf16(y[0], y[1]); w.y = pg8::cvt_pk_bf16(y[2], y[3]); w.z = pg8::cvt_pk_bf16(y[4], y[5]); w.w = pg8::cvt_pk_bf16(y[6], y[7]);
                        *(u32x4*)(rowp + bj * 128) = w;
                    }
                } else {
#pragma unroll
                    for (int bj = 0; bj < 2; ++bj) {
                        const f32x4 v0 = acc[ai][bj][m][0], v1 = acc[ai][bj][m][1];
                        u32x4 w; w.x = pg8::cvt_pk_bf16(v0[0], v0[1]); w.y = pg8::cvt_pk_bf16(v0[2], v0[3]); w.z = pg8::cvt_pk_bf16(v1[0], v1[1]); w.w = pg8::cvt_pk_bf16(v1[2], v1[3]);
                        *(u32x4*)(rowp + bj * 128) = w;
                    }
                }
            }
    }
};
struct EpiOutProj {
    static constexpr bool PERM = false, AFTER_DRAIN = false;
    const float* x; const float* mod; float* xn;
    __device__ __forceinline__ void operator()(const f32x4 (&acc)[2][2][4][2], const Unit& u, int wr, int wc, int fr, int fq) const {
        const int b = u.pm / 32; const float* gt1 = mod + b * 6144 + 2048;
        const int col0 = u.pn * 256 + wc * 32 + 4 * fq;
#pragma unroll
        for (int ai = 0; ai < 2; ++ai)
#pragma unroll
            for (int m = 0; m < 4; ++m) {
                const size_t off = (size_t)(u.pm * 256 + ai * 128 + wr * 64 + m * 16 + fr) * D + col0;
#pragma unroll
                for (int bj = 0; bj < 2; ++bj)
#pragma unroll
                    for (int n = 0; n < 2; ++n) {
                        const int co = bj * 128 + n * 16;
                        const f32x4 xv = *(const f32x4*)(x + off + co), gv = *(const f32x4*)(gt1 + col0 + co);
                        *(f32x4*)(xn + off + co) = xv + gv * acc[ai][bj][m][n];
                    }
            }
    }
};
struct EpiMoeUp {
    static constexpr bool PERM = true, AFTER_DRAIN = false;
    bf16_t* hid;
    __device__ __forceinline__ void operator()(const f32x4 (&acc)[2][2][4][2], const Unit& u, int wr, int wc, int fr, int fq) const {
        const int col0 = u.pn * 128 + wc * 32 + 8 * fq;
#pragma unroll
        for (int ai = 0; ai < 2; ++ai)
#pragma unroll
            for (int m = 0; m < 4; ++m) {
                bf16_t* rowp = hid + (size_t)(u.pm * 256 + ai * 128 + wr * 64 + m * 16 + fr) * 1024 + col0;
                float y[8];
#pragma unroll
                for (int n = 0; n < 2; ++n)
#pragma unroll
                    for (int i = 0; i < 4; ++i) y[n * 4 + i] = siluf(acc[ai][0][m][n][i]) * acc[ai][1][m][n][i];
                u32x4 w; w.x = pg8::cvt_pk_bf16(y[0], y[1]); w.y = pg8::cvt_pk_bf16(y[2], y[3]); w.z = pg8::cvt_pk_bf16(y[4], y[5]); w.w = pg8::cvt_pk_bf16(y[6], y[7]);
                *(u32x4*)rowp = w;
            }
    }
};
struct EpiMoeDown {
    static constexpr bool PERM = true, AFTER_DRAIN = false;
    bf16_t* ye; const float* gatel;
    __device__ __forceinline__ void operator()(const f32x4 (&acc)[2][2][4][2], const Unit& u, int wr, int wc, int fr, int fq) const {
        const int col0 = u.pn * 256 + wc * 32 + 8 * fq;
#pragma unroll
        for (int ai = 0; ai < 2; ++ai)
#pragma unroll
            for (int m = 0; m < 4; ++m) {
                const int r = u.pm * 256 + ai * 128 + wr * 64 + m * 16 + fr; const float gv = gatel[r];
                bf16_t* rowp = ye + (size_t)r * 1024 + col0;
#pragma unroll
                for (int bj = 0; bj < 2; ++bj) {
                    const f32x4 v0 = acc[ai][bj][m][0] * gv, v1 = acc[ai][bj][m][1] * gv;
                    u32x4 w; w.x = pg8::cvt_pk_bf16(v0[0], v0[1]); w.y = pg8::cvt_pk_bf16(v0[2], v0[3]); w.z = pg8::cvt_pk_bf16(v1[0], v1[1]); w.w = pg8::cvt_pk_bf16(v1[2], v1[3]);
                    *(u32x4*)(rowp + bj * 128) = w;
                }
            }
    }
};

__device__ __forceinline__ unsigned pk2(float lo, float hi) { return (unsigned)f2bf(lo) | ((unsigned)f2bf(hi) << 16); }
__device__ __forceinline__ void transpose_item(const float* W, int ldw, int k0, int n0, bf16_t* WT, int K, int dst_row0, LAS float* scr, int lane) {
    {
        const int kq = lane >> 3, n4 = (lane & 7) * 4;
        f32x4 wv[8];
#pragma unroll
        for (int i = 0; i < 8; ++i) wv[i] = *(const f32x4*)(W + (size_t)(k0 + kq + 8 * i) * ldw + n0 + n4);
#pragma unroll
        for (int i = 0; i < 8; ++i) { LAS float* sp = scr + (kq + 8 * i) * 33 + n4; sp[0] = wv[i][0]; sp[1] = wv[i][1]; sp[2] = wv[i][2]; sp[3] = wv[i][3]; }
    }
    asm volatile("s_waitcnt lgkmcnt(0)" ::: "memory");
    const int c = lane & 7;
#pragma unroll
    for (int j = 0; j < 4; ++j) { const int n = (lane >> 3) + 8 * j; const LAS float* s = scr + (8 * c) * 33 + n;
        uint4 o; o.x = pk2(s[0 * 33], s[1 * 33]); o.y = pk2(s[2 * 33], s[3 * 33]); o.z = pk2(s[4 * 33], s[5 * 33]); o.w = pk2(s[6 * 33], s[7 * 33]);
        *(uint4*)(WT + (size_t)(dst_row0 + n) * K + k0 + 8 * c) = o; }
    asm volatile("s_waitcnt lgkmcnt(0)" ::: "memory");
}
__device__ __forceinline__ void ph_convert_small(ArgsRef a, unsigned char* lds_raw) {
    const int tix_ = tid_fresh();
    const int lane = tix_ & 63, wave = tix_ >> 6;
    LAS float* scr = (LAS float*)((LAS unsigned char*)lds_raw + wave * 16384);
    const int gw = blockIdx.x * 8 + wave, NGW = gridDim.x * 8;
    bf16_t* WinT = (bf16_t*)(a.ws + WS_WIN_T);
    constexpr int I_IN = 16 * 112;
    for (int it = gw; it < I_IN; it += NGW) { const int kb = it / 112, nb = it % 112; transpose_item(a.w_in, INC, 64 * kb, 32 * nb, WinT, 1024, 32 * nb, scr, lane); }
    float* rope = (float*)(a.ws + WS_ROPE);
    for (int i = blockIdx.x * NT + tix_; i < 128 * 16; i += gridDim.x * NT) {
        const int pos = i >> 4, j = i & 15;
        const float ang = (float)pos * powf(10000.f, -(float)(2 * j) / 32.f);
        rope[2 * i] = cosf(ang); rope[2 * i + 1] = sinf(ang);
    }
}
__device__ __forceinline__ void convert_moe_chunk(ArgsRef a, unsigned char* lds_raw, int c, int tix) {
    const int lane = tix & 63, wave = tix >> 6;
    LAS float* scr = (LAS float*)((LAS unsigned char*)lds_raw + wave * 16384);
    bf16_t* Wgu = (bf16_t*)(a.ws + WS_WGU); bf16_t* Wd = (bf16_t*)(a.ws + WS_WD);
    const int it = c * 8 + wave;
    if (c >= 3072) { const int r = it - 3072 * 8; const int kb = r / 32, nb = r % 32; transpose_item(a.w_out, 1024, 64 * kb, 32 * nb, (bf16_t*)(a.ws + WS_WOUT_T), 1024, 32 * nb, scr, lane); return; }
    const int nb = it & 31, kb = (it >> 5) & 15, e = (it >> 9) & 15, mat = it >> 13;
    const int n0 = 32 * nb, k0 = 64 * kb;
    if (mat < 2) transpose_item((mat == 0 ? a.w_gate : a.w_up) + (size_t)e * 1024 * 1024, 1024, k0, n0, Wgu + (size_t)e * 2048 * 1024, 1024, 256 * (n0 >> 7) + mat * 128 + (n0 & 127), scr, lane);
    else transpose_item(a.w_down + (size_t)e * 1024 * 1024, 1024, k0, n0, Wd + (size_t)e * 1024 * 1024, 1024, n0, scr, lane);
}
namespace att {
using bf16x8 = __attribute__((ext_vector_type(8))) short;
using s16x4 = __attribute__((ext_vector_type(4))) short;
using f32x16 = __attribute__((ext_vector_type(16))) float;
typedef short v4i16_t __attribute__((ext_vector_type(4)));
constexpr int KV = 64, NTILE = LT / KV, SLOTB = 32768, NSLOT = 3;
constexpr int OFF_WSF = 4 * SLOTB;
constexpr int OFF_UW = 160 * 1024 - 256 + 128;
__device__ __forceinline__ int crow(int r, int hi) { return (r & 3) + 8 * (r >> 2) + 4 * hi; }
__device__ __forceinline__ void glds16(const void* gsrc, unsigned lds_dst) { unsigned keep;
    asm volatile("s_mov_b32 %0, m0\n\ts_mov_b32 m0, %2\n\ts_nop 0\n\tglobal_load_lds_dwordx4 %1, off\n\ts_mov_b32 m0, %0" : "=&s"(keep) : "v"(gsrc), "s"(lds_dst) : "memory"); }
__device__ __forceinline__ void glds16s(const void* sbase, unsigned voff, unsigned lds_dst) { unsigned keep;
    asm volatile("s_mov_b32 %0, m0\n\ts_mov_b32 m0, %3\n\ts_nop 0\n\tglobal_load_lds_dwordx4 %2, %1\n\ts_mov_b32 m0, %0" : "=&s"(keep) : "s"(sbase), "v"(voff), "s"(lds_dst) : "memory"); }
__device__ __forceinline__ s16x4 vtr(const LAS unsigned char* p) { return __builtin_bit_cast(s16x4, __builtin_amdgcn_ds_read_tr16_b64_v4i16((LAS v4i16_t*)p)); }
__device__ __forceinline__ unsigned cvtpk(float lo, float hi) { return cvt2bf(lo, hi); }
#define ATT_BAR_V(N) asm volatile("s_waitcnt vmcnt(" #N ") lgkmcnt(0)\n\ts_barrier" ::: "memory")
#define ATT_BAR() asm volatile("s_waitcnt lgkmcnt(0)\n\ts_barrier" ::: "memory")

#define SBAR() __builtin_amdgcn_sched_barrier(0)
__device__ __forceinline__ void attn_unit(ArgsRef a, unsigned char* shm, int b, int h, int qb, int tile0, int NTS  , bf16_t* POp  , size_t po_map_stride, float* MLp  , size_t ml_map_stride) {
    const int tid = tid_fresh(), lane = tid & 63, r32 = lane & 31, hi = lane >> 5;
    const int wid = __builtin_amdgcn_readfirstlane(tid >> 6);
    const int map = wid >> 2, qs = wid & 3;
    const bf16_t* Q = (const bf16_t*)(a.ws + WS_QG); const bf16_t* Kb = (const bf16_t*)(a.ws + WS_K); const bf16_t* Vb = (const bf16_t*)(a.ws + WS_V);
    const size_t m0 = (size_t)b * L + qb * 128 + qs * 32;
    const bf16_t* Kh = Kb + ((size_t)b * LT + (size_t)tile0 * KV) * 512 + h * 128;
    const bf16_t* Vh = Vb + ((size_t)b * LT + (size_t)tile0 * KV) * 512 + h * 128;
    const unsigned lds0 = (unsigned)(uintptr_t)shm;
    const LAS unsigned char* shm3 = (const LAS unsigned char*)shm;
    LAS float* wsf = (LAS float*)(shm3 + OFF_WSF) + wid * 64;
    bf16x8 qr[4];
#pragma unroll
    for (int d0 = 0; d0 < 4; ++d0) qr[d0] = *(const bf16x8*)(Q + (m0 + r32) * 1024 + h * 128 + map * 64 + 16 * d0 + 8 * hi);
    const int drow0 = 8 * wid + (lane >> 4), drow1 = drow0 + 4, dc = lane & 15;
    const unsigned ko0 = (unsigned)(drow0 * 1024 + (dc ^ (drow0 & 15)) * 16), ko1 = (unsigned)(drow1 * 1024 + (dc ^ (drow1 & 15)) * 16);
    const unsigned vo0 = (unsigned)(drow0 * 1024 + ((((dc >> 2) ^ (drow0 & 3)) << 2) | (dc & 3)) * 16), vo1 = (unsigned)(drow1 * 1024 + ((((dc >> 2) ^ (drow1 & 3)) << 2) | (dc & 3)) * 16);
    const unsigned kdst = lds0 + (2 * wid) * 1024, vdst = lds0 + 16384 + (2 * wid) * 1024;
#define A2_DMA1(piece, t, slot) do { const unsigned char* kt_ = (const unsigned char*)Kh + (size_t)(t) * KV * 1024; const unsigned char* vt_ = (const unsigned char*)Vh + (size_t)(t) * KV * 1024; const unsigned so_ = (unsigned)(slot) * SLOTB; \
        if ((piece) == 0) glds16s(kt_, ko0, (unsigned)__builtin_amdgcn_readfirstlane(kdst + so_)); else if ((piece) == 1) glds16s(kt_, ko1, (unsigned)__builtin_amdgcn_readfirstlane(kdst + so_ + 1024)); \
        else if ((piece) == 2) glds16s(vt_, vo0, (unsigned)__builtin_amdgcn_readfirstlane(vdst + so_)); else glds16s(vt_, vo1, (unsigned)__builtin_amdgcn_readfirstlane(vdst + so_ + 1024)); } while (0)
#define A2_DMA(t, slot) do { A2_DMA1(0, t, slot); A2_DMA1(1, t, slot); A2_DMA1(2, t, slot); A2_DMA1(3, t, slot); } while (0)
    A2_DMA(0, 0); A2_DMA(1, 1);
    __builtin_amdgcn_s_waitcnt(0);
    const int q4 = (lane & 15) >> 2;
    int kof[4], vof[4];
#pragma unroll
    for (int d0 = 0; d0 < 4; ++d0) { kof[d0] = r32 * 256 + (((8 * map + 2 * d0 + hi) ^ (r32 & 15)) << 4);
                                     vof[d0] = 16384 + (4 * hi + q4) * 256 + ((lane >> 4) & 1) * 32 + (lane & 3) * 8 + ((d0 ^ q4) << 6); }
    f32x16 o[4];
#pragma unroll
    for (int d0 = 0; d0 < 4; ++d0)
#pragma unroll
        for (int r = 0; r < 16; ++r) o[d0][r] = 0.f;
    float mref = 0.f, lsum = 0.f;
    f32x16 negm;
#pragma unroll
    for (int r = 0; r < 16; ++r) negm[r] = 0.f;
    f32x16 pA0, pA1, pB0, pB1;
    bf16x8 pw[4];
#define A2_ROWMAX(C0, C1, rm) do { float rm2_; rm = __builtin_fmaxf(__builtin_fmaxf(C0[0], C1[0]), C0[1]); rm2_ = __builtin_fmaxf(__builtin_fmaxf(C1[1], C0[2]), C1[2]); \
        _Pragma("unroll") for (int r = 3; r < 15; r += 2) { rm = __builtin_fmaxf(__builtin_fmaxf(rm, C0[r]), C1[r]); rm2_ = __builtin_fmaxf(__builtin_fmaxf(rm2_, C0[r + 1]), C1[r + 1]); } \
        rm = __builtin_fmaxf(__builtin_fmaxf(rm, C0[15]), C1[15]); rm = __builtin_fmaxf(rm, rm2_); \
        { auto sw_ = __builtin_amdgcn_permlane32_swap(__float_as_uint(rm), __float_as_uint(rm), false, false); rm = __builtin_fmaxf(__uint_as_float(sw_[0]), __uint_as_float(sw_[1])); } } while (0)
#define A2_RESCALE_O(alpha) do { if (hi == 0) wsf[r32] = (alpha); \
        _Pragma("unroll") for (int r = 0; r < 16; ++r) { const float f = wsf[crow(r, hi)]; _Pragma("unroll") for (int d0 = 0; d0 < 4; ++d0) o[d0][r] *= f; } } while (0)
#define A2_VF(g) (bf16x8){vlo[(g) % 3][0], vlo[(g) % 3][1], vlo[(g) % 3][2], vlo[(g) % 3][3], vhi[(g) % 3][0], vhi[(g) % 3][1], vhi[(g) % 3][2], vhi[(g) % 3][3]}
#define A2_VRD(g) do { vlo[(g) % 3] = vtr(vb + vof[(g) >> 2] + ((g) & 3) * 4096); vhi[(g) % 3] = vtr(vb + vof[(g) >> 2] + ((g) & 3) * 4096 + 2048); } while (0)
    ATT_BAR_V(0);
    A2_DMA(2, 2);
    {
        const LAS unsigned char* kb = shm3;
        pA0 = negm; pA1 = negm;
#pragma unroll
        for (int d0 = 0; d0 < 4; ++d0) { const bf16x8 k0 = *(const LAS bf16x8*)(kb + kof[d0]), k1 = *(const LAS bf16x8*)(kb + kof[d0] + 8192);
            pA0 = __builtin_amdgcn_mfma_f32_32x32x16_bf16(k0, qr[d0], pA0, 0, 0, 0); pA1 = __builtin_amdgcn_mfma_f32_32x32x16_bf16(k1, qr[d0], pA1, 0, 0, 0); }
        float rm; A2_ROWMAX(pA0, pA1, rm);
        if (__any(rm > 8.f)) { const float dl = fmaxf(rm, 0.f); mref += dl;
#pragma unroll
            for (int r = 0; r < 16; ++r) { pA0[r] -= dl; pA1[r] -= dl; negm[r] = -mref; } }
#pragma unroll
        for (int r = 0; r < 16; ++r) { pA0[r] = __builtin_amdgcn_exp2f(pA0[r]); pA1[r] = __builtin_amdgcn_exp2f(pA1[r]); }
    }
#define A2_STEP(C0, C1, P0, P1, t_, DO_DMA) do { \
        const LAS unsigned char* kb = shm3 + ((t_) & 3) * SLOTB; const LAS unsigned char* vb = shm3 + (((t_) - 1) & 3) * SLOTB; \
        bf16x8 kf[3];     \
        kf[0] = *(const LAS bf16x8*)(kb + kof[0]); kf[1] = *(const LAS bf16x8*)(kb + kof[0] + 8192); \
        s16x4 vlo[3], vhi[3]; \
        C0 = negm; C1 = negm; float sacc = 0.f; u32x4 w_[4]; SBAR(); \
        _Pragma("unroll") for (int i = 0; i < 8; ++i) { \
            if (i + 2 < 8) kf[(i + 2) % 3] = *(const LAS bf16x8*)(kb + kof[(i + 2) >> 1] + ((i + 2) & 1) * 8192); \
            if (i == 6) A2_VRD(0); if (i == 7) A2_VRD(1); \
            if (i & 1) C1 = __builtin_amdgcn_mfma_f32_32x32x16_bf16(kf[i % 3], qr[i >> 1], C1, 0, 0, 0); else C0 = __builtin_amdgcn_mfma_f32_32x32x16_bf16(kf[i % 3], qr[i >> 1], C0, 0, 0, 0); \
            const int e_ = 4 * (i & 3); \
            if (i < 4) { sacc += P0[e_]; sacc += P0[e_ + 1]; sacc += P0[e_ + 2]; sacc += P0[e_ + 3]; asm volatile("" : "+v"(sacc)); w_[i >> 1][(i & 1) * 2] = cvtpk(P0[e_], P0[e_ + 1]); w_[i >> 1][(i & 1) * 2 + 1] = cvtpk(P0[e_ + 2], P0[e_ + 3]); } \
            else       { sacc += P1[e_]; sacc += P1[e_ + 1]; sacc += P1[e_ + 2]; sacc += P1[e_ + 3]; asm volatile("" : "+v"(sacc)); w_[i >> 1][(i & 1) * 2] = cvtpk(P1[e_], P1[e_ + 1]); w_[i >> 1][(i & 1) * 2 + 1] = cvtpk(P1[e_ + 2], P1[e_ + 3]); } \
            asm volatile("" : "+v"(w_[i >> 1]));     \
            SBAR(); } \
        lsum += sacc; \
        _Pragma("unroll") for (int k_ = 0; k_ < 4; ++k_) pw[k_] = __builtin_bit_cast(bf16x8, w_[k_]); \
        float rm; A2_ROWMAX(C0, C1, rm); \
        const bool resc = __any(rm > 8.f); float alpha = 1.f; \
        if (resc) { const float dl = fmaxf(rm, 0.f); mref += dl; alpha = __builtin_amdgcn_exp2f(-dl); \
            _Pragma("unroll") for (int r = 0; r < 16; ++r) { C0[r] -= dl; C1[r] -= dl; negm[r] = -mref; } } \
        SBAR(); \
        _Pragma("unroll") for (int g = 0; g < 16; ++g) { \
            if (g + 2 < 16) A2_VRD(g + 2); \
            o[g >> 2] = __builtin_amdgcn_mfma_f32_32x32x16_bf16(pw[g & 3], A2_VF(g), o[g >> 2], 0, 0, 0); \
            if (g < 8) { C0[2 * g] = __builtin_amdgcn_exp2f(C0[2 * g]); C0[2 * g + 1] = __builtin_amdgcn_exp2f(C0[2 * g + 1]); asm volatile("" : "+v"(C0)); } \
            else { C1[2 * (g - 8)] = __builtin_amdgcn_exp2f(C1[2 * (g - 8)]); C1[2 * (g - 8) + 1] = __builtin_amdgcn_exp2f(C1[2 * (g - 8) + 1]); asm volatile("" : "+v"(C1)); } \
            if (DO_DMA && (g & 3) == 3) A2_DMA1(g >> 2, (t_) + 2, ((t_) + 2) & 3); \
            SBAR(); } \
        if (resc) { lsum *= alpha; A2_RESCALE_O(alpha); } } while (0)
    int t = 1;
    for (; t + 3 < NTS; t += 2) {
        ATT_BAR_V(4); A2_STEP(pB0, pB1, pA0, pA1, t, true);
        ATT_BAR_V(4); A2_STEP(pA0, pA1, pB0, pB1, t + 1, true);
    }
    ATT_BAR_V(4); A2_STEP(pB0, pB1, pA0, pA1, t, true); ++t;
    ATT_BAR_V(4); A2_STEP(pA0, pA1, pB0, pB1, t, false); ++t;
    ATT_BAR_V(0); A2_STEP(pB0, pB1, pA0, pA1, t, false);
    {
        float sacc = 0.f;
#pragma unroll
        for (int r = 0; r < 16; ++r) sacc += pB0[r] + pB1[r];
        lsum += sacc;
#pragma unroll
        for (int s = 0; s < 2; ++s) { u32x4 w0, w1;
            w0.x = cvtpk(pB0[8 * s], pB0[8 * s + 1]); w0.y = cvtpk(pB0[8 * s + 2], pB0[8 * s + 3]); w0.z = cvtpk(pB0[8 * s + 4], pB0[8 * s + 5]); w0.w = cvtpk(pB0[8 * s + 6], pB0[8 * s + 7]);
            w1.x = cvtpk(pB1[8 * s], pB1[8 * s + 1]); w1.y = cvtpk(pB1[8 * s + 2], pB1[8 * s + 3]); w1.z = cvtpk(pB1[8 * s + 4], pB1[8 * s + 5]); w1.w = cvtpk(pB1[8 * s + 6], pB1[8 * s + 7]);
            pw[s] = __builtin_bit_cast(bf16x8, w0); pw[2 + s] = __builtin_bit_cast(bf16x8, w1); }
        const LAS unsigned char* vb = shm3 + ((NTS - 1) & 3) * SLOTB;
#pragma unroll
        for (int d0 = 0; d0 < 4; ++d0)
#pragma unroll
            for (int k2 = 0; k2 < 4; ++k2) { const s16x4 lo = vtr(vb + vof[d0] + k2 * 4096), hv = vtr(vb + vof[d0] + k2 * 4096 + 2048);
                const bf16x8 vf = {lo[0], lo[1], lo[2], lo[3], hv[0], hv[1], hv[2], hv[3]};
                o[d0] = __builtin_amdgcn_mfma_f32_32x32x16_bf16(pw[k2], vf, o[d0], 0, 0, 0); }
    }
#undef A2_STEP
#undef A2_VRD
#undef A2_VF
#undef A2_ROWMAX
#undef A2_DMA
#undef A2_DMA1
    const float lt = lsum + __shfl_xor(lsum, 32);
    const float inv = 1.f / lt;
    ATT_BAR();
    if (hi == 0) wsf[r32] = inv;
#pragma unroll
    for (int r = 0; r < 16; ++r) { const float f = wsf[crow(r, hi)];
#pragma unroll
        for (int d0 = 0; d0 < 4; ++d0) o[d0][r] *= f; }
    bf16_t* PO = POp + (size_t)map * po_map_stride;
    LAS bf16_t* stg = (LAS bf16_t*)shm3 + wid * 4096;
#pragma unroll
    for (int d0 = 0; d0 < 4; ++d0)
#pragma unroll
        for (int r = 0; r < 16; ++r) stg[crow(r, hi) * 128 + 32 * d0 + r32] = f2bf(o[d0][r]);
    asm volatile("s_waitcnt lgkmcnt(0)" ::: "memory");
#pragma unroll
    for (int i = 0; i < 8; ++i) { const int row = i * 4 + (lane >> 4), ch = lane & 15;
        const u32x4 v = *(const LAS u32x4*)(stg + row * 128 + ch * 8);
        *(u32x4*)(PO + (size_t)(qs * 32 + row) * 512 + h * 128 + ch * 8) = v; }
    if (hi == 0) { float2 ml; ml.x = mref; ml.y = lt; *(float2*)(MLp + (size_t)map * ml_map_stride + ((size_t)(qs * 32 + r32) * 4 + h) * 2) = ml; }
    ATT_BAR();
}
#undef SBAR
}
__device__ __forceinline__ void ph_attn(ArgsRef a, unsigned char* shm, int pass = 0) {
    const int tix_ = tid_fresh();
    unsigned* cnt = (unsigned*)(a.ws + WS_CTL) + 8192 + pass * 1024;
    volatile LAS int* uw = (volatile LAS int*)((LAS unsigned char*)shm + att::OFF_UW);
    for (;;) {
        if (tix_ == 0) {
            int u = -1; const int q = blockIdx.x & 7;
            for (int s = 0; s < 8; ++s) { const int k = (q + s) & 7; const unsigned v = __hip_atomic_fetch_add(cnt + k * 64, 1u, __ATOMIC_RELAXED, __HIP_MEMORY_SCOPE_AGENT); if (v < (unsigned)(2 * QB4 + 4 * NQ4)) { u = k * 256 + (int)v; break; } }
            uw[0] = u;
        }
        __syncthreads();
        const int u = uw[0];
        __syncthreads();
        if (u < 0) break;
        const int bh = u >> 8, v = u & 255, b = bh >> 2, h = bh & 3;
        int qb, tile0, nt, sp;
        if (v < 2 * QB4) { sp = v / QB4; qb = v % QB4; tile0 = sp * 66; nt = 66; }
        else { const int w = v - 2 * QB4; qb = QB4 + w % NQ4; sp = w / NQ4; tile0 = sp == 0 ? 0 : sp == 1 ? 34 : sp == 2 ? 66 : 100; nt = (sp & 1) ? 32 : 34; }
        const size_t row0 = (size_t)b * L + qb * 128;
        bf16_t* POp; float* MLp; size_t pstr, mstr;
        if (sp < 2) { POp = (bf16_t*)(a.ws + (sp == 0 ? WS_PO0 : WS_PO2)) + row0 * 512; pstr = (sp == 0 ? (WS_PO1 - WS_PO0) : (WS_PO3 - WS_PO2)) / 2; MLp = (float*)(a.ws + WS_ML) + ((size_t)(2 * sp) * M + row0) * 8; mstr = (size_t)M * 8; }
        else { const size_t rowx = (size_t)b * (NQ4 * 128) + (qb - QB4) * 128; POp = (bf16_t*)(a.ws + WS_POX) + ((size_t)(sp - 2) * 2 * NX4 + rowx) * 512; pstr = (size_t)NX4 * 512; MLp = (float*)(a.ws + WS_MLX) + ((size_t)(sp - 2) * 2 * NX4 + rowx) * 8; mstr = (size_t)NX4 * 8; }
        att::attn_unit(a, shm, b, h, qb, tile0, nt, POp, pstr, MLp, mstr);
    }
    if (pass) return;
    unsigned* ctl = (unsigned*)(a.ws + WS_CTL);
    if (tix_ == 0) { unsigned sp = 0; while (__hip_atomic_load(ctl + 12288, __ATOMIC_RELAXED, __HIP_MEMORY_SCOPE_AGENT) < 16u && ++sp < (1u << 22)) __builtin_amdgcn_s_sleep(8); }
    __syncthreads();
    for (;;) {
        if (tix_ == 0) uw[0] = (int)__hip_atomic_fetch_add(ctl + 12288 + 64, 1u, __ATOMIC_RELAXED, __HIP_MEMORY_SCOPE_AGENT);
        __syncthreads();
        const int c = uw[0];
        __syncthreads();
        if (c >= 2048 + 64) break;
        convert_moe_chunk(a, shm, c < 2048 ? c : c + 1024, tix_);
    }
}
__device__ __forceinline__ void ph_fill_wdown(ArgsRef a, unsigned char* shm) {
    const int tix_ = tid_fresh();
    unsigned* ctl = (unsigned*)(a.ws + WS_CTL);
    volatile LAS int* uw = (volatile LAS int*)((LAS unsigned char*)shm + att::OFF_UW);
    for (;;) {
        if (tix_ == 0) uw[0] = (int)__hip_atomic_fetch_add(ctl + 12288 + 128, 1u, __ATOMIC_RELAXED, __HIP_MEMORY_SCOPE_AGENT);
        __syncthreads();
        const int c = uw[0];
        __syncthreads();
        if (c >= 1024) break;
        convert_moe_chunk(a, shm, 2048 + c, tix_);
    }
}

__device__ __forceinline__ int gdn_row(int d, int b, int cs, int i) {
    const bool isctx = cs < 4; const int n = isctx ? cs : cs - 4; const int len = isctx ? LC : L; const int base = b * LT + (isctx ? 0 : LC);
    const int p = n * 64 + i; return base + (d == 0 ? p : len - 1 - p);
}
namespace gdn {
using bf16x8 = __attribute__((ext_vector_type(8))) short;
using f32x16 = __attribute__((ext_vector_type(16))) float;
__device__ __forceinline__ int crow(int r, int hi) { return (r & 3) + 8 * (r >> 2) + 4 * hi; }
__device__ __forceinline__ int pch(int x) { return 2 * (x >> 4) + ((x >> 2) & 1); }
__device__ __forceinline__ int pj(int x) { return 4 * ((x >> 3) & 1) + (x & 3); }
__device__ __forceinline__ unsigned cvtpk(float lo, float hi) { return cvt2bf(lo, hi); }
__device__ __forceinline__ bf16x8 pack8(const f32x16& x, int s) {
    u32x4 w; w.x = cvtpk(x[8 * s], x[8 * s + 1]); w.y = cvtpk(x[8 * s + 2], x[8 * s + 3]); w.z = cvtpk(x[8 * s + 4], x[8 * s + 5]); w.w = cvtpk(x[8 * s + 6], x[8 * s + 7]);
    return __builtin_bit_cast(bf16x8, w);
}
#define GDN_MFMA(A, B, C) __builtin_amdgcn_mfma_f32_32x32x16_bf16((A), (B), (C), 0, 0, 0)
typedef short v4i16g __attribute__((ext_vector_type(4)));
using s16x4 = __attribute__((ext_vector_type(4))) short;
__device__ __forceinline__ s16x4 vtr(const LAS unsigned char* p) { return __builtin_bit_cast(s16x4, __builtin_amdgcn_ds_read_tr16_b64_v4i16((LAS v4i16g*)p)); }
__device__ __forceinline__ bf16x8 trfrag(const LAS unsigned char* img, int r0, int r1, int tile, int lane) {
    const int q = (lane & 15) >> 2, po = ((lane >> 4) & 1) * 32 + (lane & 3) * 8;
    const s16x4 lo = vtr(img + (r0 + q) * 256 + ((tile ^ q) << 6) + po), hv = vtr(img + (r1 + q) * 256 + ((tile ^ q) << 6) + po);
    return (bf16x8){lo[0], lo[1], lo[2], lo[3], hv[0], hv[1], hv[2], hv[3]};
}
constexpr int AQK_GL_OFF = 4096;
constexpr int P_KNA = 0, P_QNA = 16384, P_KBT = 32768, P_VBT = 49152, P_QDS = 65536, P_KDTS = 81920, P_AF = 98304, P_TF = 115200, P_TIMG = 132096, P_GS = 140288, P_MT = 141312, P_MT2 = 143488;
__device__ __forceinline__ void prep(ArgsRef a, unsigned char* shm) {
    LAS unsigned char* s3 = (LAS unsigned char*)shm;
    LAS bf16_t* KnA = (LAS bf16_t*)(s3 + P_KNA); LAS bf16_t* QnA = (LAS bf16_t*)(s3 + P_QNA); LAS bf16_t* KBt = (LAS bf16_t*)(s3 + P_KBT); LAS bf16_t* VBt = (LAS bf16_t*)(s3 + P_VBT);
    LAS bf16_t* QDs = (LAS bf16_t*)(s3 + P_QDS); LAS bf16_t* KDTs = (LAS bf16_t*)(s3 + P_KDTS);
    LAS float* Af = (LAS float*)(s3 + P_AF); LAS float* Tf = (LAS float*)(s3 + P_TF); LAS bf16_t* TImg = (LAS bf16_t*)(s3 + P_TIMG);
    LAS float* gc = (LAS float*)(s3 + P_GS); LAS float* be = gc + 64; LAS float* eg = gc + 128; LAS float* ekd = gc + 192;
    LAS float* Mt = (LAS float*)(s3 + P_MT); LAS float* Mt2 = (LAS float*)(s3 + P_MT2);
    const bf16_t* GQKVr = (const bf16_t*)(a.ws + WS_GQKV);
    unsigned char* WN = a.ws + WS_WN; unsigned char* QD = a.ws + WS_QD; unsigned char* AQK = a.ws + WS_AQK; unsigned char* UB = a.ws + WS_UB; unsigned char* KDT = a.ws + WS_KDT; float* GL = (float*)(a.ws + WS_GL);
    const int t0 = tid_fresh();
    const int w = __builtin_amdgcn_readfirstlane(t0 >> 6);
    u32x4 nxm[6], nx0[6], nxp[6]; float ngx = 0.f, ngb = 0.f;
#define PREP_FETCH(ci_) do { const int cs_ = (ci_) % NCH, h_ = ((ci_) / NCH) & 3, b_ = ((ci_) / (NCH * 4)) % NB, d_ = (ci_) / (NCH * 4 * NB); \
        _Pragma("unroll") for (int kk = 0; kk < 6; ++kk) { const int p = t0 + NT * kk, mat = kk >> 1, row = (p >> 4) & 63, ch = p & 15; \
            const int r = gdn_row(d_, b_, cs_, row), j = r % LT; \
            const bool has_prev = !(j == 0 || j == LC), has_next = !(j == LC - 1 || j == LT - 1); \
            const bf16_t* gp = GQKVr + (size_t)r * 1536 + mat * 512 + h_ * 128 + ch * 8; \
            const u32x4 z = {0u, 0u, 0u, 0u}; \
            nx0[kk] = *(const u32x4*)gp; nxm[kk] = has_prev ? *(const u32x4*)(gp - 1536) : z; nxp[kk] = has_next ? *(const u32x4*)(gp + 1536) : z; } \
        if (t0 < 64) { const float* abr = (const float*)(a.ws + WS_AB) + (size_t)gdn_row(d_, b_, cs_, t0) * 16 + d_ * 4 + h_; ngx = abr[0]; ngb = abr[8]; } } while (0)
    if ((int)blockIdx.x < NCI) PREP_FETCH((int)blockIdx.x);
    for (int ci = blockIdx.x; ci < NCI; ci += gridDim.x) {
        const int cs = ci % NCH, h = (ci / NCH) & 3, b = (ci / (NCH * 4)) % NB, d = ci / (NCH * 4 * NB);
        const bool lat = cs >= 4;
        int t = t0; asm volatile("" : "+v"(t));
        const int lane = t & 63, r32 = lane & 31, hi = lane >> 5;
        u32x4 rawm[6], raw0[6], rawp[6];
#pragma unroll
        for (int kk = 0; kk < 6; ++kk) { rawm[kk] = nxm[kk]; raw0[kk] = nx0[kk]; rawp[kk] = nxp[kk]; }
        const float gxa = ngx, gxb = ngb;
        __syncthreads();
        if (ci + (int)gridDim.x < NCI) PREP_FETCH(ci + (int)gridDim.x);
        if (t < 64) {
            const float xa = gxa + a.dt_bias[d * 4 + h];
            float g = -expf(a.a_log[d * 4 + h]) * (fmaxf(xa, 0.f) + log1pf(expf(-fabsf(xa))));
            const float bt = 1.f / (1.f + expf(-gxb));
#pragma unroll
            for (int o = 1; o < 64; o <<= 1) { const float v = __shfl_up(g, o); if (lane >= o) g += v; }
            const float gl = __shfl(g, 63);
            gc[t] = g; be[t] = bt; eg[t] = __expf(g); ekd[t] = __expf(gl - g);
            if (t == 63) *(float*)(AQK + (size_t)ci * 8192 + AQK_GL_OFF) = __expf(g);
        }
        for (int i = t; i < 64 * 65; i += NT) Tf[i] = 0.f;
        __syncthreads();
        float cw[3][8];
#pragma unroll
        for (int kk = 0; kk < 6; ++kk) {
            const int p = t + NT * kk, mat = kk >> 1, row = (p >> 4) & 63, ch = p & 15;
            float v[8]; float ss = 0.f;
            if ((kk & 1) == 0) {
                const float* cwp = a.conv_w + mat * 512 + h * 128 + ch * 8;
#pragma unroll
                for (int tp = 0; tp < 3; ++tp) { const f32x4 c0v = *(const f32x4*)(cwp + tp * 1536), c1v = *(const f32x4*)(cwp + tp * 1536 + 4);
                    cw[tp][0] = c0v[0]; cw[tp][1] = c0v[1]; cw[tp][2] = c0v[2]; cw[tp][3] = c0v[3]; cw[tp][4] = c1v[0]; cw[tp][5] = c1v[1]; cw[tp][6] = c1v[2]; cw[tp][7] = c1v[3]; }
            }
#pragma unroll
            for (int e = 0; e < 8; ++e) {
                const unsigned wm = rawm[kk][e >> 1], w0 = raw0[kk][e >> 1], wp = rawp[kk][e >> 1];
                const float fm = (e & 1) ? __uint_as_float(wm & 0xffff0000u) : __uint_as_float(wm << 16);
                const float f0 = (e & 1) ? __uint_as_float(w0 & 0xffff0000u) : __uint_as_float(w0 << 16);
                const float fp = (e & 1) ? __uint_as_float(wp & 0xffff0000u) : __uint_as_float(wp << 16);
                v[e] = siluf(cw[0][e] * fm + cw[1][e] * f0 + cw[2][e] * fp); ss += v[e] * v[e]; }
            if (mat < 2) {
                ss += __shfl_xor(ss, 1); ss += __shfl_xor(ss, 2); ss += __shfl_xor(ss, 4); ss += __shfl_xor(ss, 8);
                const float sc = rsqrtf(ss + EPS) * (mat == 0 ? 0.08838834764831845f : 1.f);
#pragma unroll
                for (int e = 0; e < 8; ++e) v[e] *= sc;
            }
            u32x4 raw; raw.x = pk2(v[0], v[1]); raw.y = pk2(v[2], v[3]); raw.z = pk2(v[4], v[5]); raw.w = pk2(v[6], v[7]);
#pragma unroll
            for (int e = 0; e < 8; ++e) v[e] = (e & 1) ? __uint_as_float(raw[e >> 1] & 0xffff0000u) : __uint_as_float(raw[e >> 1] << 16);
            if (mat == 1) {
                *(LAS u32x4*)(KnA + (ch * 64 + row) * 8) = raw;
                const float s1 = be[row] * eg[row], s2 = ekd[row];
                const int pos = row * 128 + (((((ch >> 2) ^ (row & 3)) << 2) | (ch & 3)) * 8);
                u32x4 w1, w2; w1.x = pk2(v[0] * s1, v[1] * s1); w1.y = pk2(v[2] * s1, v[3] * s1); w1.z = pk2(v[4] * s1, v[5] * s1); w1.w = pk2(v[6] * s1, v[7] * s1);
                w2.x = pk2(v[0] * s2, v[1] * s2); w2.y = pk2(v[2] * s2, v[3] * s2); w2.z = pk2(v[4] * s2, v[5] * s2); w2.w = pk2(v[6] * s2, v[7] * s2);
                *(LAS u32x4*)(KBt + pos) = w1; *(LAS u32x4*)(KDTs + pos) = w2;
            } else if (mat == 0) {
                *(LAS u32x4*)(QnA + (ch * 64 + row) * 8) = raw;
                if (lat) {
                    const float s = eg[row];
                    u32x2 q0, q1; q0.x = pk2(v[0] * s, v[1] * s); q0.y = pk2(v[2] * s, v[3] * s); q1.x = pk2(v[4] * s, v[5] * s); q1.y = pk2(v[6] * s, v[7] * s);
                    const int cb = 2 * (ch >> 1), jo = 4 * (ch & 1);
                    *(LAS u32x2*)(QDs + ((cb + 0) * 64 + row) * 8 + jo) = q0;
                    *(LAS u32x2*)(QDs + ((cb + 1) * 64 + row) * 8 + jo) = q1;
                }
            } else {
                const float s = be[row];
                const int pos = row * 128 + (((((ch >> 2) ^ (row & 3)) << 2) | (ch & 3)) * 8);
                u32x4 w1; w1.x = pk2(v[0] * s, v[1] * s); w1.y = pk2(v[2] * s, v[3] * s); w1.z = pk2(v[4] * s, v[5] * s); w1.w = pk2(v[6] * s, v[7] * s);
                *(LAS u32x4*)(VBt + pos) = w1;
            }
        }
        __syncthreads();
        if (w < 3 || (w < 6 && lat)) {
            const int job = w < 3 ? w : w - 3; const int it = job == 0 ? 0 : 1, jt = job == 2 ? 1 : 0;
            f32x16 acc;
#pragma unroll
            for (int r = 0; r < 16; ++r) acc[r] = 0.f;
            if (w < 3) {
#pragma unroll
                for (int ks = 0; ks < 8; ++ks) {
                    const bf16x8 fa = *(const LAS bf16x8*)(KnA + ((2 * ks + hi) * 64 + 32 * it + r32) * 8), fb = *(const LAS bf16x8*)(KnA + ((2 * ks + hi) * 64 + 32 * jt + r32) * 8);
                    acc = GDN_MFMA(fa, fb, acc);
                }
                const int j = 32 * jt + r32; const float gj = gc[j];
#pragma unroll
                for (int r = 0; r < 16; ++r) { const int i = 32 * it + crow(r, hi); Af[i * 65 + j] = (j < i) ? be[i] * acc[r] * __expf(gc[i] - gj) : 0.f; }
            } else {
#pragma unroll
                for (int ks = 0; ks < 8; ++ks) {
                    const bf16x8 fa = *(const LAS bf16x8*)(KnA + ((2 * ks + hi) * 64 + 32 * jt + r32) * 8), fb = *(const LAS bf16x8*)(QnA + ((2 * ks + hi) * 64 + 32 * it + r32) * 8);
                    acc = GDN_MFMA(fa, fb, acc);
                }
                const int i = 32 * it + r32; const float gi = gc[i];
#pragma unroll
                for (int r = 0; r < 16; ++r) { const int j = 32 * jt + crow(r, hi); acc[r] = (j <= i) ? acc[r] * __expf(gi - gc[j]) : 0.f; }
#pragma unroll
                for (int s = 0; s < 2; ++s) { const bf16x8 pk = pack8(acc, s); *(bf16x8*)(AQK + (size_t)ci * 8192 + ((2 * (2 * jt + s) + hi) * 64 + i) * 16) = pk; }
            }
        }
        __syncthreads();
        if (t < 64) {
            const int blk = t >> 4, c = t & 15, o = 16 * blk; float x[16];
#pragma unroll
            for (int i = 0; i < 16; ++i) {
                float s = 0.f;
#pragma unroll
                for (int j = 0; j < i; ++j) s += Af[(o + i) * 65 + o + j] * x[j];
                x[i] = (i == c ? 1.f : 0.f) - s;
            }
#pragma unroll
            for (int i = 0; i < 16; ++i) Tf[(o + i) * 65 + o + c] = x[i];
        }
        __syncthreads();
        { const int pq = t >> 8, i = (t >> 4) & 15, c = t & 15, o = 32 * pq; float s = 0.f;
#pragma unroll
          for (int j = 0; j < 16; ++j) s += Af[(o + 16 + i) * 65 + o + j] * Tf[(o + j) * 65 + o + c];
          Mt[(pq * 16 + i) * 17 + c] = s; }
        __syncthreads();
        { const int pq = t >> 8, i = (t >> 4) & 15, c = t & 15, o = 32 * pq; float s = 0.f;
#pragma unroll
          for (int j = 0; j < 16; ++j) s += Tf[(o + 16 + i) * 65 + o + 16 + j] * Mt[(pq * 16 + j) * 17 + c];
          Tf[(o + 16 + i) * 65 + o + c] = -s; }
        __syncthreads();
#pragma unroll
        for (int k = 0; k < 2; ++k) { const int e = t + NT * k, i = e >> 5, c = e & 31; float s = 0.f;
#pragma unroll 8
            for (int j = 0; j < 32; ++j) s += Af[(32 + i) * 65 + j] * Tf[j * 65 + c];
            Mt2[i * 33 + c] = s; }
        __syncthreads();
#pragma unroll
        for (int k = 0; k < 2; ++k) { const int e = t + NT * k, i = e >> 5, c = e & 31; float s = 0.f;
#pragma unroll 8
            for (int j = 0; j < 32; ++j) s += Tf[(32 + i) * 65 + 32 + j] * Mt2[j * 33 + c];
            Tf[(32 + i) * 65 + c] = -s; }
        __syncthreads();
        { const int i = t >> 3, ch = t & 7; u32x4 o;
          o.x = pk2(Tf[i * 65 + 8 * ch], Tf[i * 65 + 8 * ch + 1]); o.y = pk2(Tf[i * 65 + 8 * ch + 2], Tf[i * 65 + 8 * ch + 3]);
          o.z = pk2(Tf[i * 65 + 8 * ch + 4], Tf[i * 65 + 8 * ch + 5]); o.w = pk2(Tf[i * 65 + 8 * ch + 6], Tf[i * 65 + 8 * ch + 7]);
          *(LAS u32x4*)(TImg + (ch * 64 + i) * 8) = o; }
        __syncthreads();
        {
            const int dkt = w >> 1, it = w & 1; const int nks = it == 0 ? 2 : 4;
            f32x16 acc;
#pragma unroll
            for (int r = 0; r < 16; ++r) acc[r] = 0.f;
#pragma unroll
            for (int ks = 0; ks < 4; ++ks) if (ks < nks) {
                const bf16x8 fa = trfrag((const LAS unsigned char*)KBt, 16 * ks + 8 * hi, 16 * ks + 8 * hi + 4, dkt, lane), fb = *(const LAS bf16x8*)(TImg + ((2 * ks + hi) * 64 + 32 * it + r32) * 8);
                acc = GDN_MFMA(fa, fb, acc);
            }
#pragma unroll
            for (int r = 0; r < 16; ++r) acc[r] = -acc[r];
            const int i = 32 * it + r32;
#pragma unroll
            for (int s = 0; s < 2; ++s) { const bf16x8 pk = pack8(acc, s); *(bf16x8*)(WN + (size_t)ci * 16384 + ((2 * (2 * dkt + s) + hi) * 64 + i) * 16) = pk; }
        }
        {
            const int it = w >> 2, dvt = w & 3; const int nks = it == 0 ? 2 : 4;
            f32x16 acc;
#pragma unroll
            for (int r = 0; r < 16; ++r) acc[r] = 0.f;
#pragma unroll
            for (int ks = 0; ks < 4; ++ks) if (ks < nks) {
                const bf16x8 fa = *(const LAS bf16x8*)(TImg + ((2 * ks + hi) * 64 + 32 * it + r32) * 8), fb = trfrag((const LAS unsigned char*)VBt, 16 * ks + 8 * hi, 16 * ks + 8 * hi + 4, dvt, lane);
                acc = GDN_MFMA(fa, fb, acc);
            }
            unsigned char* dst = UB + (size_t)ci * 16384 + ((it * 4 + dvt) * 64 + lane) * 32;
            *(bf16x8*)dst = pack8(acc, 0); *(bf16x8*)(dst + 16) = pack8(acc, 1);
        }
        for (int i = t; i < 1024; i += NT) {
            *(u32x4*)(KDT + (size_t)ci * 16384 + i * 16) = *(const LAS u32x4*)((const LAS unsigned char*)KDTs + i * 16);
            if (lat) *(u32x4*)(QD + (size_t)ci * 16384 + i * 16) = *(const LAS u32x4*)((const LAS unsigned char*)QDs + i * 16);
        }
    }
}
constexpr int SB_WN = 0, SB_QD = 16384, SB_KDT = 32768, SB_AQK = 49152, SBUF = 57344, SB_UB0 = 2 * SBUF;
__device__ __forceinline__ void glds16(const void* gsrc, unsigned lds_dst) { unsigned keep;
    asm volatile("s_mov_b32 %0, m0\n\ts_mov_b32 m0, %2\n\ts_nop 0\n\tglobal_load_lds_dwordx4 %1, off\n\ts_mov_b32 m0, %0" : "=&s"(keep) : "v"(gsrc), "s"(lds_dst) : "memory"); }
#define SCAN_STEP(LAT_) do { \
            const LAS unsigned char* bb = s3 + buf * SBUF; \
            const float gl = *(const LAS float*)(bb + SB_AQK + AQK_GL_OFF); \
            f32x16 U[2]; \
_Pragma("unroll") \
            for (int mt = 0; mt < 2; ++mt) { \
                const LAS u32x4* up = (const LAS u32x4*)(s3 + SB_UB0 + buf * 16384 + ((mt * 4 + sl) * 64 + lane) * 32); \
                const u32x4 u0 = up[0], u1 = up[1]; \
_Pragma("unroll") \
                for (int e = 0; e < 4; ++e) { U[mt][2 * e] = __uint_as_float(u0[e] << 16); U[mt][2 * e + 1] = __uint_as_float(u0[e] & 0xffff0000u); \
                                              U[mt][8 + 2 * e] = __uint_as_float(u1[e] << 16); U[mt][8 + 2 * e + 1] = __uint_as_float(u1[e] & 0xffff0000u); } \
            } \
            f32x16 OT[2]; \
_Pragma("unroll") \
            for (int it = 0; it < 2; ++it) \
_Pragma("unroll") \
                for (int r = 0; r < 16; ++r) OT[it][r] = 0.f; \
_Pragma("unroll") \
            for (int ks = 0; ks < 8; ++ks) { \
                const bf16x8 sb = pack8(S[ks >> 1], ks & 1); \
_Pragma("unroll") \
                for (int mt = 0; mt < 2; ++mt) { \
                    const bf16x8 fw = *(const LAS bf16x8*)(bb + SB_WN + ((2 * ks + hi) * 64 + 32 * mt + r32) * 16); \
                    U[mt] = GDN_MFMA(fw, sb, U[mt]); \
                    if (LAT_) { const bf16x8 fq = *(const LAS bf16x8*)(bb + SB_QD + ((2 * ks + hi) * 64 + 32 * mt + r32) * 16); OT[mt] = GDN_MFMA(sb, fq, OT[mt]); } \
                } \
            } \
            bf16x8 Ub[4]; \
_Pragma("unroll") \
            for (int k2 = 0; k2 < 4; ++k2) Ub[k2] = pack8(U[k2 >> 1], k2 & 1); \
            if (LAT_) { \
_Pragma("unroll") \
                for (int it = 0; it < 2; ++it) \
_Pragma("unroll") \
                    for (int k2 = 0; k2 < 4; ++k2) if (!(it == 0 && k2 >= 2)) { \
                        const bf16x8 fa = *(const LAS bf16x8*)(bb + SB_AQK + ((2 * k2 + hi) * 64 + 32 * it + r32) * 16); \
                        OT[it] = GDN_MFMA(Ub[k2], fa, OT[it]); \
                    } \
_Pragma("unroll") \
                for (int it = 0; it < 2; ++it) { \
                    const int r = gdn_row(d, b, cs, 32 * it + r32); const size_t m = (size_t)b * L + ((r % LT) - LC); \
                    float* op = OGDN + ((size_t)d * M + m) * 512 + h * 128 + 32 * sl + 4 * hi; \
_Pragma("unroll") \
                    for (int q = 0; q < 4; ++q) { const float4 v = make_float4(OT[it][4 * q], OT[it][4 * q + 1], OT[it][4 * q + 2], OT[it][4 * q + 3]); *(float4*)(op + 8 * q) = v; } \
                } \
            } \
_Pragma("unroll") \
            for (int dt = 0; dt < 4; ++dt) { \
_Pragma("unroll") \
                for (int r = 0; r < 16; ++r) S[dt][r] *= gl; \
_Pragma("unroll") \
                for (int k2 = 0; k2 < 4; ++k2) { \
                    const bf16x8 fk = trfrag(bb + SB_KDT, 16 * k2 + 4 * hi, 16 * k2 + 8 + 4 * hi, dt, lane); \
                    S[dt] = GDN_MFMA(fk, Ub[k2], S[dt]); \
                } \
            } \
        } while (0)
__device__ __forceinline__ void scan_item(ArgsRef a, unsigned char* shm, int d, int b, int h) {
    const LAS unsigned char* s3 = (const LAS unsigned char*)shm;
    const unsigned lds0 = (unsigned)(uintptr_t)shm;
    const unsigned char* WN = a.ws + WS_WN; const unsigned char* QD = a.ws + WS_QD; const unsigned char* AQK = a.ws + WS_AQK; const unsigned char* UB = a.ws + WS_UB; const unsigned char* KDT = a.ws + WS_KDT;
    float* OGDN = a.out;
    const int t = tid_fresh(), lane = t & 63, r32 = lane & 31, hi = lane >> 5;
    const int w = __builtin_amdgcn_readfirstlane(t >> 6);
    const bool comp = w < 4; const int sl = w & 3;
    const int ci0 = ((d * NB + b) * 4 + h) * NCH;
    const unsigned lo = (unsigned)(w * 1024 + lane * 16);
#define SCAN_DMA(ci_, buf_) do { const size_t c16_ = (size_t)(ci_) * 16384; const unsigned db_ = lds0 + (buf_) * SBUF + w * 1024; \
        glds16(WN + c16_ + lo, (unsigned)__builtin_amdgcn_readfirstlane(db_ + SB_WN)); glds16(WN + c16_ + 8192 + lo, (unsigned)__builtin_amdgcn_readfirstlane(db_ + SB_WN + 8192)); \
        glds16(QD + c16_ + lo, (unsigned)__builtin_amdgcn_readfirstlane(db_ + SB_QD)); glds16(QD + c16_ + 8192 + lo, (unsigned)__builtin_amdgcn_readfirstlane(db_ + SB_QD + 8192)); \
        glds16(KDT + c16_ + lo, (unsigned)__builtin_amdgcn_readfirstlane(db_ + SB_KDT)); glds16(KDT + c16_ + 8192 + lo, (unsigned)__builtin_amdgcn_readfirstlane(db_ + SB_KDT + 8192)); \
        glds16(AQK + (size_t)(ci_) * 8192 + lo, (unsigned)__builtin_amdgcn_readfirstlane(db_ + SB_AQK)); } while (0)
#define SCAN_UB(ci_, buf_) do { if (!comp) { const u32x4* g_ = (const u32x4*)(UB + (size_t)(ci_) * 16384) + (w - 4) * 256 + lane; LAS u32x4* l_ = (LAS u32x4*)((LAS unsigned char*)shm + SB_UB0 + (buf_) * 16384) + (w - 4) * 256 + lane; \
        const u32x4 x0_ = g_[0], x1_ = g_[64], x2_ = g_[128], x3_ = g_[192]; l_[0] = x0_; l_[64] = x1_; l_[128] = x2_; l_[192] = x3_; } } while (0)
    f32x16 S[4];
#pragma unroll
    for (int dt = 0; dt < 4; ++dt)
#pragma unroll
        for (int r = 0; r < 16; ++r) S[dt][r] = 0.f;
    SCAN_DMA(ci0, 0); SCAN_UB(ci0, 0);
    for (int cs = 0; cs < NCH; ++cs) {
        const int ci = ci0 + cs, buf = cs & 1; const bool lat = cs >= 4;
        asm volatile("s_waitcnt vmcnt(0) lgkmcnt(0)\n\ts_barrier" ::: "memory");
        if (cs + 1 < NCH) { SCAN_DMA(ci + 1, buf ^ 1); SCAN_UB(ci + 1, buf ^ 1); }
        if (comp) { if (lat) SCAN_STEP(true); else SCAN_STEP(false); }
    }
    asm volatile("s_waitcnt vmcnt(0) lgkmcnt(0)\n\ts_barrier" ::: "memory");
#undef SCAN_DMA
#undef SCAN_UB
#undef SCAN_STEP
}
}
__device__ __forceinline__ void ph_gdn_scan(ArgsRef a, unsigned char* shm) {
    for (int it = blockIdx.x; it < 16; it += gridDim.x) {
        gdn::scan_item(a, shm, it >> 3, (it >> 2) & 1, it & 3);
        if (threadIdx.x == 0) __hip_atomic_fetch_add((unsigned*)(a.ws + WS_CTL) + 12288, 1u, __ATOMIC_RELAXED, __HIP_MEMORY_SCOPE_AGENT);
    }
}
__device__ __forceinline__ void ph_gdn_out(ArgsRef a) {
    const int tix_ = tid_fresh();
    const float* OGDN = a.out; bf16_t* QG = (bf16_t*)(a.ws + WS_QG);
    const float* ML = (const float*)(a.ws + WS_ML);
    const float lam = ((const float*)(a.ws + WS_MOD))[3 * 6144];
    const int lane = tix_ & 63, h = lane >> 4;
    f32x4 gn0 = *(const f32x4*)(a.gdn_norm_g + (lane & 15) * 8), gn1 = *(const f32x4*)(a.gdn_norm_g + (lane & 15) * 8 + 4);
    f32x4 sg0 = *(const f32x4*)(a.subg + (lane & 15) * 8), sg1 = *(const f32x4*)(a.subg + (lane & 15) * 8 + 4);
    for (size_t m = (size_t)blockIdx.x * 8 + (tix_ >> 6); m < (size_t)M; m += (size_t)gridDim.x * 8) {
        const size_t off = m * 512 + lane * 8;
        {
            const f32x4 a0 = *(const f32x4*)(OGDN + off), a1 = *(const f32x4*)(OGDN + off + 4), b0 = *(const f32x4*)(OGDN + (size_t)M * 512 + off), b1 = *(const f32x4*)(OGDN + (size_t)M * 512 + off + 4);
            const f32x4 o0 = a0 + b0, o1 = a1 + b1;
            float ss = (o0[0] * o0[0] + o0[1] * o0[1]) + (o0[2] * o0[2] + o0[3] * o0[3]) + (o1[0] * o1[0] + o1[1] * o1[1]) + (o1[2] * o1[2] + o1[3] * o1[3]);
            ss += __shfl_xor(ss, 1); ss += __shfl_xor(ss, 2); ss += __shfl_xor(ss, 4); ss += __shfl_xor(ss, 8);
            const float rinv = rsqrtf(ss * (1.f / 128.f) + EPS);
            u32x4* gp = (u32x4*)(QG + m * 1024 + 512 + lane * 8);
            const u32x4 gw = *gp;
            float y[8];
#pragma unroll
            for (int e = 0; e < 8; ++e) { const float gv = (e & 1) ? __uint_as_float(gw[e >> 1] & 0xffff0000u) : __uint_as_float(gw[e >> 1] << 16);
                const float ov = e < 4 ? o0[e] : o1[e - 4], gg = e < 4 ? gn0[e] : gn1[e - 4]; y[e] = ov * rinv * gg * siluf(gv); }
            u32x4 w; w.x = pk2(y[0], y[1]); w.y = pk2(y[2], y[3]); w.z = pk2(y[4], y[5]); w.w = pk2(y[6], y[7]);
            *gp = w;
        }
        {
            float on[2][8];
            const int tq = (int)(m % L); const bool four = tq >= QB4 * 128;
            const size_t rx = (m / L) * (size_t)(NQ4 * 128) + (size_t)(four ? tq - QB4 * 128 : 0);
            const float* MLX = (const float*)(a.ws + WS_MLX); const bf16_t* POX = (const bf16_t*)(a.ws + WS_POX);
#pragma unroll
            for (int mp = 0; mp < 2; ++mp) {
                const float2 ml0 = *(const float2*)(ML + (((size_t)(0 + mp) * M + m) * 4 + h) * 2), ml1 = *(const float2*)(ML + (((size_t)(2 + mp) * M + m) * 4 + h) * 2);
                const u32x4 p0 = *(const u32x4*)((const bf16_t*)(a.ws + (mp == 0 ? WS_PO0 : WS_PO1)) + off), p1 = *(const u32x4*)((const bf16_t*)(a.ws + (mp == 0 ? WS_PO2 : WS_PO3)) + off);
                float2 ml2 = make_float2(-1e30f, 0.f), ml3 = ml2; u32x4 p2 = {0u, 0u, 0u, 0u}, p3 = p2;
                if (four) {
                    ml2 = *(const float2*)(MLX + (((size_t)(0 + mp) * NX4 + rx) * 4 + h) * 2); ml3 = *(const float2*)(MLX + (((size_t)(2 + mp) * NX4 + rx) * 4 + h) * 2);
                    p2 = *(const u32x4*)(POX + ((size_t)(0 + mp) * NX4 + rx) * 512 + lane * 8); p3 = *(const u32x4*)(POX + ((size_t)(2 + mp) * NX4 + rx) * 512 + lane * 8);
                }
                const float mx = fmaxf(fmaxf(ml0.x, ml1.x), fmaxf(ml2.x, ml3.x));
                const float w0 = ml0.y * __builtin_amdgcn_exp2f(ml0.x - mx), w1 = ml1.y * __builtin_amdgcn_exp2f(ml1.x - mx), w2 = ml2.y * __builtin_amdgcn_exp2f(ml2.x - mx), w3 = ml3.y * __builtin_amdgcn_exp2f(ml3.x - mx);
                const float iw = __builtin_amdgcn_rcpf((w0 + w1) + (w2 + w3));
#pragma unroll
                for (int e = 0; e < 8; ++e) { const float x0 = (e & 1) ? __uint_as_float(p0[e >> 1] & 0xffff0000u) : __uint_as_float(p0[e >> 1] << 16), x1 = (e & 1) ? __uint_as_float(p1[e >> 1] & 0xffff0000u) : __uint_as_float(p1[e >> 1] << 16);
                    const float x2 = (e & 1) ? __uint_as_float(p2[e >> 1] & 0xffff0000u) : __uint_as_float(p2[e >> 1] << 16), x3 = (e & 1) ? __uint_as_float(p3[e >> 1] & 0xffff0000u) : __uint_as_float(p3[e >> 1] << 16);
                    on[mp][e] = ((w0 * x0 + w1 * x1) + (w2 * x2 + w3 * x3)) * iw; }
            }
            float dd[8]; float ss = 0.f;
#pragma unroll
            for (int e = 0; e < 8; ++e) { dd[e] = on[0][e] - lam * on[1][e]; ss += dd[e] * dd[e]; }
            ss += __shfl_xor(ss, 1); ss += __shfl_xor(ss, 2); ss += __shfl_xor(ss, 4); ss += __shfl_xor(ss, 8);
            const float rinv = rsqrtf(ss * (1.f / 128.f) + EPS) * 0.8f;
            u32x4 w; w.x = pk2(dd[0] * rinv * sg0[0], dd[1] * rinv * sg0[1]); w.y = pk2(dd[2] * rinv * sg0[2], dd[3] * rinv * sg0[3]);
            w.z = pk2(dd[4] * rinv * sg1[0], dd[5] * rinv * sg1[1]); w.w = pk2(dd[6] * rinv * sg1[2], dd[7] * rinv * sg1[3]);
            *(u32x4*)(QG + m * 1024 + lane * 8) = w;
        }
    }
}

__device__ __forceinline__ void ph_topk(ArgsRef a, unsigned* lds) {
    const int tix_ = tid_fresh();
    const float* aff = (const float*)(a.ws + WS_AFF); int* IDXL = (int*)(a.ws + WS_IDXL); float* GATEL = (float*)(a.ws + WS_GATEL); int* SLOT = (int*)(a.ws + WS_SLOT);
    unsigned* hist = lds;
    unsigned* shp = lds + 2048;
    unsigned* wsum = lds + 2052;
    unsigned* wsum2 = lds + 2060;
    unsigned* csum = lds + 2068;
    const int t = tix_, lane = t & 63, w = t >> 6;
    for (int it = blockIdx.x; it < 32; it += gridDim.x) {
        const int e = it & 15, b = it >> 4;
        unsigned key[16];
#pragma unroll
        for (int i = 0; i < 16; ++i) key[i] = __float_as_uint(aff[((size_t)b * L + t * 16 + i) * 16 + e]);
        unsigned prefix = 0, need = 1024;
        for (int pass = 0; pass < 4; ++pass) {
            const int shift = 24 - 8 * pass;
            __syncthreads();
            for (int i = t; i < 2048; i += NT) hist[i] = 0;
            __syncthreads();
            const unsigned himask = pass == 0 ? 0u : (0xffffffffu << (shift + 8));
#pragma unroll
            for (int i = 0; i < 16; ++i) if ((key[i] & himask) == prefix) atomicAdd(&hist[w * 256 + ((key[i] >> shift) & 255)], 1u);
            __syncthreads();
            unsigned hsum = 0, cum = 0;
            if (t < 256) {
#pragma unroll
                for (int ww = 0; ww < 8; ++ww) hsum += hist[ww * 256 + 255 - t];
                cum = hsum;
#pragma unroll
                for (int o = 1; o < 64; o <<= 1) { const unsigned x1 = __shfl_up(cum, o); if (lane >= o) cum += x1; }
                if (lane == 63) csum[w] = cum;
            }
            __syncthreads();
            if (t < 256) {
                unsigned off = 0;
                for (int ww = 0; ww < w; ++ww) off += csum[ww];
                cum += off;
                if (cum >= need && cum - hsum < need) { shp[0] = prefix | ((unsigned)(255 - t) << shift); shp[1] = need - (cum - hsum); }
            }
            __syncthreads();
            prefix = shp[0]; need = shp[1];
        }
        const unsigned thr = prefix;
        unsigned ngt = 0, neq = 0;
#pragma unroll
        for (int i = 0; i < 16; ++i) { ngt += key[i] > thr; neq += key[i] == thr; }
        unsigned sg = ngt, se = neq;
#pragma unroll
        for (int o = 1; o < 64; o <<= 1) { const unsigned x1 = __shfl_up(sg, o), x2 = __shfl_up(se, o); if (lane >= o) { sg += x1; se += x2; } }
        __syncthreads();
        if (lane == 63) { wsum[w] = sg; wsum2[w] = se; }
        __syncthreads();
        unsigned og = 0, oe = 0, total_gt = 0;
        for (int i = 0; i < 8; ++i) { if (i < w) { og += wsum[i]; oe += wsum2[i]; } total_gt += wsum[i]; }
        unsigned pg = og + sg - ngt, pe = oe + se - neq;
        const int grp = b * 16 + e;
#pragma unroll
        for (int i = 0; i < 16; ++i) {
            const int tok = t * 16 + i; int slot = -1;
            if (key[i] > thr) { slot = (int)pg; ++pg; }
            else if (key[i] == thr) { if (pe < need) slot = (int)(total_gt + pe); ++pe; }
            SLOT[((size_t)b * L + tok) * 16 + e] = slot;
            if (slot >= 0) { IDXL[grp * 1024 + slot] = tok; GATEL[grp * 1024 + slot] = __uint_as_float(key[i]); }
        }
    }
}

__device__ __forceinline__ void ph_final(ArgsRef a) {
    const int tix_ = tid_fresh();
    float* xio = a.out; const bf16_t* YE = (const bf16_t*)(a.ws + WS_YE); const int* SLOT = (const int*)(a.ws + WS_SLOT); const float* mod = (const float*)(a.ws + WS_MOD);
    const bf16_t* zrow = (const bf16_t*)(a.ws + WS_CTL + 60 * 1024);
    const int lane = tix_ & 63;
    const int row0 = blockIdx.x * 8 + (tix_ >> 6), rstep = gridDim.x * 8;
    int slotn = -1; float4 xn[4];
    if (row0 < M) { if (lane < 16) slotn = SLOT[(size_t)row0 * 16 + lane];
#pragma unroll
        for (int j = 0; j < 4; ++j) xn[j] = *(const float4*)(xio + (size_t)row0 * D + 4 * lane + 256 * j); }
    for (int row = row0; row < M; row += rstep) {
        const int b = row / L;
        const int slotv = slotn; float4 xc[4];
#pragma unroll
        for (int j = 0; j < 4; ++j) xc[j] = xn[j];
        ushort4 yv[16][4];
#pragma unroll
        for (int e = 0; e < 16; ++e) {
            const int slot = __builtin_amdgcn_readlane(slotv, e);
            const bf16_t* yr = slot >= 0 ? YE + ((size_t)(b * 16 + e) * 1024 + slot) * 1024 : zrow;
#pragma unroll
            for (int j = 0; j < 4; ++j) yv[e][j] = *(const ushort4*)(yr + 4 * lane + 256 * j);
        }
        { const int rn = row + rstep; if (rn < M) { if (lane < 16) slotn = SLOT[(size_t)rn * 16 + lane];
#pragma unroll
            for (int j = 0; j < 4; ++j) xn[j] = *(const float4*)(xio + (size_t)rn * D + 4 * lane + 256 * j); } }
        float acc[16];
#pragma unroll
        for (int i = 0; i < 16; ++i) acc[i] = 0.f;
#pragma unroll
        for (int e = 0; e < 16; ++e)
#pragma unroll
            for (int j = 0; j < 4; ++j) { acc[4 * j] += bf2f(yv[e][j].x); acc[4 * j + 1] += bf2f(yv[e][j].y); acc[4 * j + 2] += bf2f(yv[e][j].z); acc[4 * j + 3] += bf2f(yv[e][j].w); }
        const float* gt2 = mod + b * 6144 + 5120;
        float y[16]; float ss = 0.f;
#pragma unroll
        for (int j = 0; j < 4; ++j) {
            const int k0 = 4 * lane + 256 * j;
            const float4 xv = xc[j], gg = *(const float4*)(gt2 + k0);
            y[4 * j] = xv.x + gg.x * acc[4 * j]; y[4 * j + 1] = xv.y + gg.y * acc[4 * j + 1]; y[4 * j + 2] = xv.z + gg.z * acc[4 * j + 2]; y[4 * j + 3] = xv.w + gg.w * acc[4 * j + 3];
            ss += y[4 * j] * y[4 * j] + y[4 * j + 1] * y[4 * j + 1] + y[4 * j + 2] * y[4 * j + 2] + y[4 * j + 3] * y[4 * j + 3];
        }
        ss = wave_sum(ss);
        const float rinv = rsqrtf(ss * (1.f / D) + EPS);
#pragma unroll
        for (int j = 0; j < 4; ++j) {
            const int k0 = 4 * lane + 256 * j; const float4 gg = *(const float4*)(a.final_g + k0);
            float4 o; o.x = y[4 * j] * rinv * gg.x; o.y = y[4 * j + 1] * rinv * gg.y; o.z = y[4 * j + 2] * rinv * gg.z; o.w = y[4 * j + 3] * rinv * gg.w;
            *(float4*)(xio + (size_t)row * D + k0) = o;
        }
    }
}

__device__ __forceinline__ ArgsRef fresh_args() {
    const unsigned long long p = (unsigned long long)__builtin_amdgcn_kernarg_segment_ptr();
    unsigned lo = (unsigned)p, hi = (unsigned)(p >> 32);
    asm volatile("" : "+s"(lo), "+s"(hi));
    lo = __builtin_amdgcn_readfirstlane(lo); hi = __builtin_amdgcn_readfirstlane(hi);
    return *(const __attribute__((address_space(4))) Args*)(((unsigned long long)hi << 32) | lo);
}
__global__ void __launch_bounds__(NT, 2) fwd_megakernel(Args a_in) {
#define A_ fresh_args()
    extern __shared__ __attribute__((aligned(16))) unsigned char lds_raw[];
    float* ldsf = (float*)lds_raw;
    volatile LAS unsigned* MISC = (volatile LAS unsigned*)((LAS unsigned char*)lds_raw + LDS_MISC);
    if (threadIdx.x < 64) MISC[threadIdx.x] = 0u;
    __syncthreads();
    XcdBarrier bar = xcd_barrier_post((unsigned*)(A_.ws + WS_CTL), MISC + 8);
#define GRID_BAR() xcd_barrier(bar)
    LAS unsigned char* lds3 = (LAS unsigned char*)lds_raw;
    ph_mod(A_, ldsf);
    ph_convert_small(A_, lds_raw);
    GRID_BAR();
    ph_norm<0>(A_, ldsf);
    GRID_BAR();
    { ArgsRef a = A_; unsigned char* ws = a.ws; pg8::Gemm g{(const bf16_t*)(ws + WS_H1), (const bf16_t*)(ws + WS_WIN_T), R, 3584, D, 0, 0, nullptr, 1, 0}; pg8::StaticOrder S; S.init(R, 3584, (int)gridDim.x, (int)blockIdx.x);
      EpiInProj e{(bf16_t*)(ws + WS_QG), (bf16_t*)(ws + WS_K), (bf16_t*)(ws + WS_V), (bf16_t*)(ws + WS_GQKV), (const float*)(ws + WS_ROPE)};
      pg8::gemm_phase<EpiInProj, pg8::StaticOrder, true, true>(lds3, g, S, e); }
    GRID_BAR();
    gdn::prep(A_, lds_raw);
    GRID_BAR();
    ph_gdn_scan(A_, lds_raw);
    ph_attn(A_, lds_raw);
    GRID_BAR();
    ph_gdn_out(A_);
    GRID_BAR();
    { ArgsRef a = A_; unsigned char* ws = a.ws; pg8::Gemm g{(const bf16_t*)(ws + WS_QG), (const bf16_t*)(ws + WS_WOUT_T), M, D, D, 0, 0, nullptr, 1, 0}; pg8::StaticOrder S; S.init(M, D, (int)gridDim.x, (int)blockIdx.x);
      EpiOutProj e{a.x, (const float*)(ws + WS_MOD), a.out};
      pg8::gemm_phase<EpiOutProj, pg8::StaticOrder, true, true>(lds3, g, S, e); }
    GRID_BAR();
    ph_norm<1>(A_, ldsf);
    GRID_BAR();
    ph_topk(A_, (unsigned*)ldsf);
    ph_fill_wdown(A_, lds_raw);
    GRID_BAR();
    { ArgsRef a = A_; unsigned char* ws = a.ws; pg8::Gemm g{(const bf16_t*)(ws + WS_H2), (const bf16_t*)(ws + WS_WGU), 32 * 1024, 2048, D, 4, 2048, (const int*)(ws + WS_IDXL), 64, (size_t)L * D * 2};   pg8::StaticOrder S; S.init(32 * 1024, 2048, (int)gridDim.x, (int)blockIdx.x);
      EpiMoeUp e{(bf16_t*)(ws + WS_HID)};
      pg8::gemm_phase<EpiMoeUp, pg8::StaticOrder, true, true, true>(lds3, g, S, e); }
    GRID_BAR();
    { ArgsRef a = A_; unsigned char* ws = a.ws; pg8::Gemm g{(const bf16_t*)(ws + WS_HID), (const bf16_t*)(ws + WS_WD), 32 * 1024, 1024, 1024, 4, 1024, nullptr, 1, 0}; pg8::StaticOrder S; S.init(32 * 1024, 1024, (int)gridDim.x, (int)blockIdx.x);
      EpiMoeDown e{(bf16_t*)(ws + WS_YE), (const float*)(ws + WS_GATEL)};
      pg8::gemm_phase<EpiMoeDown, pg8::StaticOrder, true, true>(lds3, g, S, e); }
    GRID_BAR();
    ph_final(A_);
}

extern "C" void kernel_launch(void* const* d_in, const int* in_sizes, int n_in, void* d_out, int out_size, void* d_ws, size_t ws_size, hipStream_t stream) {
    static int grid = 0;
    if (grid == 0) {
        if (n_in != 24 || out_size != M * D || ws_size < WS_END) { fprintf(stderr, "kernel_launch: unexpected sizes n_in %d out %d ws %zu\n", n_in, out_size, ws_size); grid = -1; return; }
        int dev = 0, cus = 0;
        if (hipGetDevice(&dev) != hipSuccess || hipDeviceGetAttribute(&cus, hipDeviceAttributeMultiprocessorCount, dev) != hipSuccess) { grid = -1; return; }
        if (hipFuncSetAttribute((const void*)fwd_megakernel, hipFuncAttributeMaxDynamicSharedMemorySize, LDS_BYTES) != hipSuccess) { fprintf(stderr, "kernel_launch: hipFuncSetAttribute failed\n"); grid = -1; return; }
        int per_cu = 0;
        if (hipOccupancyMaxActiveBlocksPerMultiprocessor(&per_cu, (const void*)fwd_megakernel, NT, LDS_BYTES) != hipSuccess || per_cu < 1) { fprintf(stderr, "kernel_launch: occupancy query says %d\n", per_cu); }
        (void)hipGetLastError();
        grid = cus;
    }
    if (grid < 0) return;
    (void)hipMemsetAsync((char*)d_ws + WS_CTL, 0, CTL_BYTES, stream);
    Args a{};
    const float** p = (const float**)&a;
    for (int i = 0; i < 24; ++i) p[i] = (const float*)d_in[i];
    a.out = (float*)d_out; a.ws = (unsigned char*)d_ws;
    hipLaunchKernelGGL(fwd_megakernel, dim3(grid), dim3(NT), LDS_BYTES, stream, a);
}
```
